# Optimizing an MI355X kernel written in HIP

```python
import jax, jax.numpy as jnp
from jax import lax
import numpy as np

D_MODEL = 1024
BATCH = 8
SEQ = 2048
DEPTH = 1

D_MIX = D_MODEL
CONV_GROUPS = 8
CONV_DIM = D_MIX // 2
CONV_KSIZE = 3
SB_HEADS = 8
SB_HEAD_DIM = 64
SB_DIM = SB_HEADS * SB_HEAD_DIM
Q_BLOCK = 128
D_FF = 4 * D_MODEL
N_MOD = 6
EPS = 1e-6
IN_SPLITS = (CONV_DIM, 2 * CONV_DIM, 3 * CONV_DIM,
             3 * CONV_DIM + SB_DIM, 3 * CONV_DIM + 2 * SB_DIM)
D_IN = 3 * CONV_DIM + 3 * SB_DIM

kernel_name = "hybrid_shortconv_stickbreaking_block"


def rms_norm(x, g):
    xf = x.astype(jnp.float32)
    y = xf * lax.rsqrt(jnp.mean(xf * xf, axis=-1, keepdims=True) + EPS)
    return (y * g.astype(jnp.float32)).astype(x.dtype)


def modulate(h, shift, scale):
    return h * (1 + scale[:, None, :]) + shift[:, None, :]


def causal_depthwise_conv(u, w):
    return lax.conv_general_dilated(
        u, w[:, None, :].astype(u.dtype), window_strides=(1,),
        padding=[(CONV_KSIZE - 1, 0)],
        dimension_numbers=("NWC", "WIO", "NWC"),
        feature_group_count=u.shape[-1])


def stick_breaking_attention(q, k, v):
    S = q.shape[1]
    scale = SB_HEAD_DIM ** -0.5
    outs = []
    for i in range(S // Q_BLOCK):
        t0, t1 = i * Q_BLOCK, (i + 1) * Q_BLOCK
        qb = q[:, t0:t1].astype(jnp.float32)
        kb = k[:, :t1].astype(jnp.float32)
        vb = v[:, :t1].astype(jnp.float32)
        z = jnp.einsum("bthd,bshd->bhts", qb, kb) * scale
        t_idx = t0 + jnp.arange(Q_BLOCK)[:, None]
        s_idx = jnp.arange(t1)[None, :]
        causal = s_idx < t_idx
        log_beta = jax.nn.log_sigmoid(z)
        log_1mb = jnp.where(causal, log_beta - z, 0.0)
        rc = lax.cumsum(log_1mb, axis=3, reverse=True)
        log_rem = jnp.concatenate(
            [rc[..., 1:], jnp.zeros_like(rc[..., :1])], axis=-1)
        a = jnp.where(causal, jnp.exp(log_beta + log_rem), 0.0)
        o = jnp.einsum("bhts,bshd->bthd", a, vb)
        outs.append(o.astype(v.dtype))
    return jnp.concatenate(outs, axis=1)


def setup_inputs(seed: int = 0) -> dict:
    key = jax.random.key(seed)
    ks = jax.random.split(key, 20)
    f32 = jnp.float32
    nrm = lambda k, shape, s: jax.random.normal(k, shape, f32) * s
    return {
        "x": nrm(ks[0], (BATCH, SEQ, D_MODEL), 1.0),
        "c": nrm(ks[1], (BATCH, D_MODEL), 1.0),
        "w_ada": nrm(ks[2], (D_MODEL, N_MOD * D_MODEL), D_MODEL ** -0.5),
        "b_ada": nrm(ks[3], (N_MOD * D_MODEL,), 0.01),
        "norm1_g": 1.0 + nrm(ks[4], (D_MODEL,), 0.02),
        "w_in": nrm(ks[5], (D_MODEL, D_IN), D_MODEL ** -0.5),
        "conv_w": nrm(ks[6], (CONV_KSIZE, CONV_DIM), CONV_KSIZE ** -0.5),
        "q_norm_g": 1.0 + nrm(ks[7], (SB_HEAD_DIM,), 0.02),
        "k_norm_g": 1.0 + nrm(ks[8], (SB_HEAD_DIM,), 0.02),
        "conv_out_g": 1.0 + nrm(ks[9], (CONV_DIM,), 0.02),
        "attn_out_g": 1.0 + nrm(ks[10], (SB_DIM,), 0.02),
        "w_out": nrm(ks[11], (D_MIX, D_MODEL), D_MIX ** -0.5),
        "norm2_g": 1.0 + nrm(ks[12], (D_MODEL,), 0.02),
        "w_ff1": nrm(ks[13], (D_MODEL, D_FF), D_MODEL ** -0.5),
        "w_ff2": nrm(ks[14], (D_FF, D_MODEL), D_FF ** -0.5),
    }


def reference(x, c, w_ada, b_ada, norm1_g, w_in, conv_w, q_norm_g, k_norm_g,
              conv_out_g, attn_out_g, w_out, norm2_g, w_ff1, w_ff2):
    B, S, D = x.shape
    mod = jax.nn.silu(c) @ w_ada + b_ada
    shift1, scale1, gate1, shift2, scale2, gate2 = jnp.split(mod, N_MOD, axis=-1)

    for _ in range(DEPTH):
        h = modulate(rms_norm(x, norm1_g), shift1, scale1)
        proj = h @ w_in
        b_gate, c_gate, u, q, k, v = jnp.split(proj, IN_SPLITS, axis=-1)

        y_conv = b_gate * causal_depthwise_conv(c_gate * u, conv_w)

        q = rms_norm(q.reshape(B, S, SB_HEADS, SB_HEAD_DIM), q_norm_g)
        k = rms_norm(k.reshape(B, S, SB_HEADS, SB_HEAD_DIM), k_norm_g)
        v = v.reshape(B, S, SB_HEADS, SB_HEAD_DIM)
        y_attn = stick_breaking_attention(q, k, v).reshape(B, S, SB_DIM)

        mix = jnp.concatenate(
            [rms_norm(y_conv, conv_out_g), rms_norm(y_attn, attn_out_g)], axis=-1)
        x = x + gate1[:, None, :] * (mix @ w_out)

        h2 = modulate(rms_norm(x, norm2_g), shift2, scale2)
        f = jnp.square(jax.nn.relu(h2 @ w_ff1)) @ w_ff2
        x = x + gate2[:, None, :] * f
    return x
```

```cpp
#include <hip/hip_runtime.h>
#include <hip/hip_cooperative_groups.h>
#include <cstdio>
#include <cstdint>
namespace cg = cooperative_groups;
__device__ __forceinline__ int lane_now() { int l; asm volatile("v_mbcnt_lo_u32_b32 %0, -1, 0\n\tv_mbcnt_hi_u32_b32 %0, -1, %0" : "=v"(l)); return l; }
namespace pg8 {
#define PG8_LAS __attribute__((address_space(3)))
typedef unsigned short bf16_t;
typedef short bf16x8 __attribute__((ext_vector_type(8)));
typedef float f32x4 __attribute__((ext_vector_type(4)));
typedef unsigned u32x4 __attribute__((ext_vector_type(4)));
constexpr int BM = 256, BK = 64, HALF = 128, HTB = HALF * BK * 2  , STAGE_BYTES = 8 * HTB, NXCD = 8, WGM = 8;

__host__ __device__ __forceinline__ int lds_byte(int r, int c) { const int st = (r >> 4) * 2 + (c >> 5), rr = r & 15, cc = c & 31, ob = rr * 64 + cc * 2; return st * 1024 + (ob ^ (((ob >> 9) & 1) << 5)); }
__host__ __device__ __forceinline__ void stage_rc(int b, int& R, int& C) { const int st = b / 1024, sb = b % 1024, swz = sb ^ (((sb >> 9) & 1) << 5); R = (st >> 1) * 16 + swz / 64; C = (st & 1) * 32 + (swz % 64) / 2; }
__host__ __device__ __forceinline__ int perm32(int rho) { const int n = rho >> 4, i = rho & 15; return 8 * (i >> 2) + 4 * n + (i & 3); }

struct Unit { int pm, pn; };
struct Gemm { const bf16_t* A; const bf16_t* Bt; int M, N, K; };

struct StaticOrder {
    int nM, nN, nwg, G, c;
    __host__ __device__ void init(int M, int N, int G_, int c_) { nM = M / BM; nN = N / BM; nwg = nM * nN; G = G_; c = c_; }
    __host__ __device__ bool next(int i, Unit& u) const {
        const long L = (long)i * G + c; if (L >= nwg) return false;
        int wgid = (int)L; { const int q = nwg / NXCD, r = nwg % NXCD, xcd = wgid % NXCD, off = wgid / NXCD; wgid = (xcd < r ? xcd * (q + 1) : r * (q + 1) + (xcd - r) * q) + off; }
        const int nig = WGM * nN, gid = wgid / nig, fm = gid * WGM, gsz = (nM - fm) < WGM ? (nM - fm) : WGM;
        u.pm = fm + ((wgid % nig) % gsz); u.pn = (wgid % nig) / gsz; return true;
    }
    __device__ __forceinline__ void a_ready(const Unit&) const {}
    __device__ __forceinline__ void done(const Unit&) const {}
};

__device__ __forceinline__ unsigned cvt_pk_bf16(float lo, float hi) { unsigned r; asm volatile("v_cvt_pk_bf16_f32 %0, %1, %2" : "=v"(r) : "v"(lo), "v"(hi)); return r; }
typedef float f32x2 __attribute__((ext_vector_type(2)));
__device__ __forceinline__ f32x2 gelu_pk(f32x2 v) {
    const f32x2 av = __builtin_elementwise_abs(v), d = av * 0.2316418882f + 1.0f;
    f32x2 t; t.x = __builtin_amdgcn_rcpf(d.x); t.y = __builtin_amdgcn_rcpf(d.y);
    f32x2 q = t * 0.5307027145f + (-0.7265760135f); q = q * t + 0.7107068705f; q = q * t + (-0.142248368f); q = q * t + 0.127414796f; q = q * t;
    const f32x2 s = (v * v) * (-0.72134752044f);
    f32x2 e; e.x = __builtin_amdgcn_exp2f(s.x); e.y = __builtin_amdgcn_exp2f(s.y);
    const f32x2 m = v * (q * e), r = v - m;
    f32x2 o; o.x = v.x < 0.f ? m.x : r.x; o.y = v.y < 0.f ? m.y : r.y; return o;
}

template <int ACT  > struct EpiBf16 {
    static constexpr bool PERM = true, AFTER_DRAIN = false; static_assert(ACT == 0 || ACT == 1, "EpiBf16: ACT is 0 (none) or 1 (gelu_pk)");
    bf16_t* O; int ldc; const float* bias; int split_cols; size_t split_stride; float scale0;
    __device__ __forceinline__ void operator()(const f32x4 (&acc)[2][2][4][2], const Unit& u, int wr, int wc, int fr, int fq) const {
        const int row0 = u.pm * BM + wr * 64 + fr; int colt = u.pn * BM; bf16_t* base = O;
        float sc = 1.f; if (split_cols) { const int t = colt / split_cols; base += (size_t)t * split_stride; colt -= t * split_cols; if (t == 0) sc = scale0; }
        const int col0 = colt + wc * 32 + 8 * fq, bcol0 = u.pn * BM + wc * 32 + 8 * fq;
        f32x4 bv[2][2];
#pragma unroll
        for (int bj = 0; bj < 2; ++bj)
#pragma unroll
            for (int n = 0; n < 2; ++n) bv[bj][n] = bias ? *(const f32x4*)(bias + bcol0 + bj * HALF + 4 * n) : (f32x4){0.f, 0.f, 0.f, 0.f};
#pragma unroll
        for (int ai = 0; ai < 2; ++ai)
#pragma unroll
            for (int m = 0; m < 4; ++m) { bf16_t* rowp = base + (size_t)(row0 + ai * HALF + m * 16) * ldc + col0;
#pragma unroll
                for (int bj = 0; bj < 2; ++bj) { f32x4 v0 = acc[ai][bj][m][0] + bv[bj][0], v1 = acc[ai][bj][m][1] + bv[bj][1];
                    if (ACT == 1) { f32x2 a = gelu_pk((f32x2){v0[0], v0[1]}), b = gelu_pk((f32x2){v0[2], v0[3]}), c = gelu_pk((f32x2){v1[0], v1[1]}), d = gelu_pk((f32x2){v1[2], v1[3]});
                        v0 = (f32x4){a.x, a.y, b.x, b.y}; v1 = (f32x4){c.x, c.y, d.x, d.y}; }
                    v0 = v0 * sc; v1 = v1 * sc; u32x4 w; w.x = cvt_pk_bf16(v0[0], v0[1]); w.y = cvt_pk_bf16(v0[2], v0[3]); w.z = cvt_pk_bf16(v1[0], v1[1]); w.w = cvt_pk_bf16(v1[2], v1[3]);
                    *(u32x4*)(rowp + bj * HALF) = w; } }
    }
};
template <int ACT> struct EpiStore {
    static constexpr bool PERM = true, AFTER_DRAIN = false, MIDK = false, SCALE = false;
    bf16_t* O; int ldc;
    __device__ __forceinline__ void operator()(const f32x4 (&acc)[2][2][4][2], const Unit& u, int ui, int wr, int wc, int fr, int fq) const {
        const int row0 = u.pm * BM + wr * 64 + fr; const int col0 = u.pn * BM + wc * 32 + 8 * fq;
#pragma unroll
        for (int ai = 0; ai < 2; ++ai)
#pragma unroll
            for (int m = 0; m < 4; ++m) { bf16_t* rowp = O + (size_t)(row0 + ai * HALF + m * 16) * ldc + col0;
#pragma unroll
                for (int bj = 0; bj < 2; ++bj) { f32x4 v0 = acc[ai][bj][m][0], v1 = acc[ai][bj][m][1];
                    if (ACT == 2) {
#pragma unroll
                        for (int e = 0; e < 4; ++e) { float a = fmaxf(v0[e], 0.f), b = fmaxf(v1[e], 0.f); v0[e] = a * a; v1[e] = b * b; } }
                    u32x4 w; w.x = cvt_pk_bf16(v0[0], v0[1]); w.y = cvt_pk_bf16(v0[2], v0[3]); w.z = cvt_pk_bf16(v1[0], v1[1]); w.w = cvt_pk_bf16(v1[2], v1[3]);
                    *(u32x4*)(rowp + bj * HALF) = w; } }
    }
};
#define PG8_TAB(lds, par) ((PG8_LAS float*)((lds) + 132096 + (par) * 3072))
struct EpiResGate {
    static constexpr bool PERM = false, AFTER_DRAIN = false, MIDK = false, SCALE = false;
    const bf16_t* base; float* out; const float* modacc; const float* bada; int goff; PG8_LAS unsigned char* lds;
    __device__ __forceinline__ void pre(const Unit& u, int ui, int tid_) const { int tid = tid_; asm volatile("" : "+v"(tid));
        if (tid < 256) { const int c = goff + u.pn * BM + tid; PG8_TAB(lds, 0)[256 + tid] = modacc[(u.pm >> 3) * 6144 + c] + bada[c]; }
    }
    __device__ __forceinline__ void operator()(const f32x4 (&acc)[2][2][4][2], const Unit& u, int ui, int wr, int wc, int fr, int fq) const {
        typedef unsigned u32x2v __attribute__((ext_vector_type(2)));
        const PG8_LAS float* tab = PG8_TAB(lds, 0) + 256;
        const int cl0 = wc * 32 + 4 * fq; const size_t off0 = (size_t)(u.pm * BM + wr * 64 + fr) * 1024 + u.pn * BM + cl0;
        u32x2v xb[2][8];
#define PG8_LDX(g, buf) do { _Pragma("unroll") for (int q_ = 0; q_ < 8; ++q_) xb[buf][q_] = *(const u32x2v*)(base + off0 + (size_t)((q_ >> 2) * HALF + (q_ & 3) * 16) * 1024 + ((g) >> 1) * HALF + ((g) & 1) * 16); } while (0)
        PG8_LDX(0, 0);
#pragma unroll
        for (int g = 0; g < 4; ++g) { const int bj = g >> 1, n = g & 1;
            if (g < 3) PG8_LDX(g + 1, (g + 1) & 1);
            const f32x4 gv = *(const PG8_LAS f32x4*)(tab + cl0 + bj * HALF + n * 16);
#pragma unroll
            for (int q = 0; q < 8; ++q) { const int ai = q >> 2, m = q & 3; const u32x2v w = xb[g & 1][q];
                const f32x4 bs = {__builtin_bit_cast(float, w.x << 16), __builtin_bit_cast(float, w.x & 0xffff0000u), __builtin_bit_cast(float, w.y << 16), __builtin_bit_cast(float, w.y & 0xffff0000u)};
                __builtin_nontemporal_store(bs + gv * acc[ai][bj][m][n], (f32x4*)(out + off0 + (size_t)(ai * HALF + m * 16) * 1024 + bj * HALF + n * 16)); } }
#undef PG8_LDX
    }
};
struct EpiWo {
    static constexpr bool PERM = false, AFTER_DRAIN = false, MIDK = false, SCALE = true;
    const float* base; bf16_t* x1b; bf16_t* xn; const float* modacc; const float* bada; const float* g2; const float* ssq_a; float* ssq2; PG8_LAS unsigned char* lds;
    __device__ __forceinline__ void pre(const Unit& u, int ui, int tid_) const { int tid = tid_; asm volatile("" : "+v"(tid));
        PG8_LAS float* tab = PG8_TAB(lds, 0);
        if (tid < 256) { const int c = u.pn * BM + tid, b = u.pm >> 3;
            tab[256 + tid] = modacc[b * 6144 + 2048 + c] + bada[2048 + c];
            tab[512 + tid] = g2[c] * (modacc[b * 6144 + 4096 + c] + bada[4096 + c] + 1.0f); }
        else tab[tid - 256] = 1.0f / sqrtf(ssq_a[u.pm * BM + tid - 256] * (1.f / 512.f) + 1e-6f);
    }
    __device__ __forceinline__ void mid(f32x4 (&acc)[2][2][4][2], const Unit& u, int ui, int wr, int wc, int fr, int fq) const {
        const PG8_LAS float* tab = PG8_TAB(lds, 0); int frp = fr; asm volatile("" : "+v"(frp));
#pragma unroll
        for (int ai = 0; ai < 2; ++ai)
#pragma unroll
            for (int m = 0; m < 4; ++m) { const float ra = tab[ai * HALF + wr * 64 + m * 16 + frp];
#pragma unroll
                for (int bj = 0; bj < 2; ++bj)
#pragma unroll
                    for (int n = 0; n < 2; ++n) acc[ai][bj][m][n] *= ra; }
    }
    __device__ __forceinline__ void operator()(const f32x4 (&acc)[2][2][4][2], const Unit& u, int ui, int wr, int wc, int fr, int fq) const {
        typedef unsigned u32x2v __attribute__((ext_vector_type(2)));
        const PG8_LAS float* tab = PG8_TAB(lds, 0);
        const int cl0 = wc * 32 + 4 * fq; const int rowb = u.pm * BM + wr * 64 + fr; const size_t off0 = (size_t)rowb * 1024 + u.pn * BM + cl0;
        float ss[8];
#pragma unroll
        for (int q = 0; q < 8; ++q) ss[q] = 0.f;
        f32x4 xb[2][4];
#define PG8_LDX(g, buf) do { _Pragma("unroll") for (int q_ = 0; q_ < 4; ++q_) xb[buf][q_] = __builtin_nontemporal_load((const f32x4*)(base + off0 + (size_t)(((g) & 1) * HALF + q_ * 16) * 1024 + ((g) >> 2) * HALF + (((g) >> 1) & 1) * 16)); } while (0)
        PG8_LDX(0, 0);
#pragma unroll
        for (int g = 0; g < 8; ++g) { const int bj = g >> 2, n = (g >> 1) & 1, ai = g & 1;
            if (g < 7) PG8_LDX(g + 1, (g + 1) & 1);
            const f32x4 gv = *(const PG8_LAS f32x4*)(tab + 256 + cl0 + bj * HALF + n * 16), av = *(const PG8_LAS f32x4*)(tab + 512 + cl0 + bj * HALF + n * 16);
#pragma unroll
            for (int m = 0; m < 4; ++m) { const size_t off = off0 + (size_t)(ai * HALF + m * 16) * 1024 + bj * HALF + n * 16;
                const f32x4 x1 = xb[g & 1][m] + gv * acc[ai][bj][m][n];
                u32x2v w; w.x = cvt_pk_bf16(x1[0], x1[1]); w.y = cvt_pk_bf16(x1[2], x1[3]);
                *(u32x2v*)(x1b + off) = w;
                ss[ai * 4 + m] += (x1[0] * x1[0] + x1[1] * x1[1]) + (x1[2] * x1[2] + x1[3] * x1[3]);
                const f32x4 y = x1 * av; w.x = cvt_pk_bf16(y[0], y[1]); w.y = cvt_pk_bf16(y[2], y[3]);
                *(u32x2v*)(xn + off) = w; } }
#undef PG8_LDX
#pragma unroll
        for (int q = 0; q < 8; ++q) { float s = ss[q]; s += __shfl_xor(s, 16); s += __shfl_xor(s, 32);
            if (fq == 0) atomicAdd(ssq2 + rowb + (q >> 2) * HALF + (q & 3) * 16, s); }
    }
};
struct EpiUp {
    static constexpr bool PERM = true, AFTER_DRAIN = false, MIDK = false, SCALE = false;
    bf16_t* O; const float* ssq2; const float* sb;
    __device__ __forceinline__ void operator()(const f32x4 (&acc)[2][2][4][2], const Unit& u, int ui, int wr, int wc, int fr, int fq) const {
        const int b = u.pm >> 3; const int row0 = u.pm * BM + wr * 64 + fr; const int col0 = u.pn * BM + wc * 32 + 8 * fq;
        f32x4 sv[2][2]; float rv[2][4];
#pragma unroll
        for (int ai = 0; ai < 2; ++ai)
#pragma unroll
            for (int m = 0; m < 4; ++m) rv[ai][m] = ssq2[row0 + ai * HALF + m * 16];
#pragma unroll
        for (int bj = 0; bj < 2; ++bj)
#pragma unroll
            for (int n = 0; n < 2; ++n) sv[bj][n] = *(const f32x4*)(sb + b * 4096 + col0 + bj * HALF + 4 * n);
#pragma unroll
        for (int ai = 0; ai < 2; ++ai)
#pragma unroll
            for (int m = 0; m < 4; ++m) { const int row = row0 + ai * HALF + m * 16; const float rinv = 1.0f / sqrtf(rv[ai][m] * (1.f / 1024.f) + 1e-6f);
                bf16_t* rowp = O + (size_t)row * 4096 + col0;
#pragma unroll
                for (int bj = 0; bj < 2; ++bj) { f32x4 v0 = acc[ai][bj][m][0] * rinv + sv[bj][0], v1 = acc[ai][bj][m][1] * rinv + sv[bj][1];
#pragma unroll
                    for (int e = 0; e < 4; ++e) { const float a = fmaxf(v0[e], 0.f), c = fmaxf(v1[e], 0.f); v0[e] = a * a; v1[e] = c * c; }
                    u32x4 w; w.x = cvt_pk_bf16(v0[0], v0[1]); w.y = cvt_pk_bf16(v0[2], v0[3]); w.z = cvt_pk_bf16(v1[0], v1[1]); w.w = cvt_pk_bf16(v1[2], v1[3]);
                    *(u32x4*)(rowp + bj * HALF) = w; } }
    }
};
template <class Epi, class Sched, bool ALIGN_EPI = false, bool SP2 = false>
__device__ __forceinline__ void gemm_phase(PG8_LAS unsigned char* lds, const Gemm g, const Sched& S, const Epi& E) {
    const int wid = __builtin_amdgcn_readfirstlane(threadIdx.x >> 6), lane = lane_now(), tid = wid * 64 + lane, wr = wid >> 2, wc = wid & 3, fr = lane & 15, fq = lane >> 4;
    const int K = g.K, nt = K / BK;
    unsigned voffA[2], voffB[2];
#pragma unroll
    for (int i = 0; i < 2; ++i) { int R, C; stage_rc(tid * 16 + i * 8192, R, C); const int Rb = Epi::PERM ? ((R & ~31) + perm32(R & 31)) : R;
        voffA[i] = (unsigned)(R * K + C) * 2u; voffB[i] = (unsigned)(Rb * K + C) * 2u; }
    const size_t kstep = (size_t)(BK * 2);
    const size_t hstep = (size_t)HALF * K * 2;
    const size_t tstep = 2 * hstep;
    const unsigned ldsw = (unsigned)wid * 1024u;
    const int aoff = lds_byte(wr * 64 + fr, fq * 8), boff = lds_byte(wc * 32 + fr, fq * 8);
#define PG8_SA(b, h) (((b) * 2 + (h)) * HTB)
#define PG8_SB(b, h) ((4 + (b) * 2 + (h)) * HTB)
#define PG8_STAGE(bufoff, gbase, voff) do { _Pragma("unroll") for (int _i = 0; _i < 2; ++_i) \
        __builtin_amdgcn_global_load_lds((const unsigned*)((const char*)(gbase) + (voff)[_i]), (PG8_LAS unsigned*)(lds + (bufoff) + ldsw + _i * 8192), 16, 0, 0); } while (0)
#define PG8_LDA(dst, b, h) do { _Pragma("unroll") for (int m = 0; m < 4; ++m) _Pragma("unroll") for (int k = 0; k < 2; ++k) dst[m][k] = *(const PG8_LAS bf16x8*)(lds + PG8_SA(b, h) + aoff + m * 2048 + k * 1024); } while (0)
#define PG8_LDB(dst, b, h) do { _Pragma("unroll") for (int n = 0; n < 2; ++n) _Pragma("unroll") for (int k = 0; k < 2; ++k) dst[n][k] = *(const PG8_LAS bf16x8*)(lds + PG8_SB(b, h) + boff + n * 2048 + k * 1024); } while (0)
#define PG8_MMA(ai, bj, At, Bt) do { __builtin_amdgcn_s_setprio(1); _Pragma("unroll") for (int m = 0; m < 4; ++m) _Pragma("unroll") for (int n = 0; n < 2; ++n) _Pragma("unroll") for (int k = 0; k < 2; ++k) \
        acc[ai][bj][m][n] = __builtin_amdgcn_mfma_f32_16x16x32_bf16(Bt[n][k], At[m][k], acc[ai][bj][m][n], 0, 0, 0); __builtin_amdgcn_s_setprio(0); } while (0)
#define PG8_WAIT_V(n) asm volatile("s_waitcnt vmcnt(" #n ")" ::: "memory")
#define PG8_WAIT_L(n) asm volatile("s_waitcnt lgkmcnt(" #n ")" ::: "memory")
#define PG8_BAR __builtin_amdgcn_s_barrier()
#define PG8_SCHED __builtin_amdgcn_sched_barrier(0)
    Unit cur, nxt; int ui = 0;
    if (!S.next(0, cur)) return;
    f32x4 acc[2][2][4][2];
#pragma unroll
    for (int a = 0; a < 2; ++a)
#pragma unroll
        for (int b = 0; b < 2; ++b)
#pragma unroll
            for (int m = 0; m < 4; ++m)
#pragma unroll
                for (int n = 0; n < 2; ++n) acc[a][b][m][n] = (f32x4){0.f, 0.f, 0.f, 0.f};
    bf16x8 At[4][2], B0[2][2], B1[2][2];
    const char* cA = (const char*)g.A + (size_t)cur.pm * tstep; const char* cB = (const char*)g.Bt + (size_t)cur.pn * tstep;
    S.a_ready(cur);
    if constexpr (SP2) {
        PG8_STAGE(PG8_SB(0, 0), cB, voffB); PG8_STAGE(PG8_SB(0, 1), cB + hstep, voffB); PG8_STAGE(PG8_SA(0, 0), cA, voffA); PG8_STAGE(PG8_SA(0, 1), cA + hstep, voffA);
        if (wr == 1) PG8_BAR;
        PG8_WAIT_V(2); PG8_BAR;
        PG8_STAGE(PG8_SB(1, 0), cB + kstep, voffB); PG8_STAGE(PG8_SA(1, 0), cA + kstep, voffA); PG8_STAGE(PG8_SB(1, 1), cB + hstep + kstep, voffB);
        PG8_WAIT_V(6); PG8_BAR;
    } else {
        PG8_STAGE(PG8_SB(0, 0), cB, voffB); PG8_STAGE(PG8_SA(0, 0), cA, voffA); PG8_STAGE(PG8_SB(0, 1), cB + hstep, voffB); PG8_STAGE(PG8_SA(0, 1), cA + hstep, voffA);
        if (wr == 1) PG8_BAR;
        PG8_WAIT_V(4); PG8_BAR;
        PG8_STAGE(PG8_SB(1, 0), cB + kstep, voffB); PG8_STAGE(PG8_SA(1, 0), cA + kstep, voffA); PG8_STAGE(PG8_SB(1, 1), cB + hstep + kstep, voffB);
        PG8_WAIT_V(6); PG8_BAR;
    }
    for (;;) {
        const bool has_next = S.next(ui + 1, nxt);
        const char* nA = has_next ? (const char*)g.A + (size_t)nxt.pm * tstep : cA; const char* nB = has_next ? (const char*)g.Bt + (size_t)nxt.pn * tstep : cB;
        for (int t = 0; t < nt; t += 2) {
            const bool last = (t == nt - 2);
            const char* a1 = cA + (size_t)(t + 1) * kstep;
            const char* a2 = last ? nA : cA + (size_t)(t + 2) * kstep; const char* b2 = last ? nB : cB + (size_t)(t + 2) * kstep;
            const char* a3 = a2 + kstep; const char* b3 = b2 + kstep;
            if (last && has_next) S.a_ready(nxt);
            if constexpr (Epi::SCALE) { if (t == nt / 2) E.mid(acc, cur, ui, wr, wc, fr, fq); }
            if constexpr (SP2) {
            PG8_LDB(B0, 0, 0); PG8_LDB(B1, 0, 1); PG8_SCHED; PG8_LDA(At, 0, 0); PG8_STAGE(PG8_SA(1, 1), a1 + hstep, voffA);
            PG8_WAIT_V(8); PG8_WAIT_L(0); PG8_BAR; PG8_MMA(0, 0, At, B0); PG8_MMA(0, 1, At, B1); PG8_BAR; PG8_SCHED;
            PG8_LDA(At, 0, 1); PG8_STAGE(PG8_SB(0, 0), b2, voffB); PG8_STAGE(PG8_SB(0, 1), b2 + hstep, voffB); PG8_STAGE(PG8_SA(0, 0), a2, voffA);
            PG8_WAIT_V(8); PG8_WAIT_L(0); PG8_BAR; PG8_MMA(1, 0, At, B0); PG8_MMA(1, 1, At, B1); PG8_BAR; PG8_SCHED;
            PG8_LDB(B0, 1, 0); PG8_LDB(B1, 1, 1); PG8_SCHED; PG8_LDA(At, 1, 0); PG8_STAGE(PG8_SA(0, 1), a2 + hstep, voffA);
            PG8_WAIT_V(8); PG8_WAIT_L(0); PG8_BAR; PG8_MMA(0, 0, At, B0); PG8_MMA(0, 1, At, B1); PG8_BAR; PG8_SCHED;
            PG8_LDA(At, 1, 1); PG8_STAGE(PG8_SB(1, 0), b3, voffB); PG8_STAGE(PG8_SB(1, 1), b3 + hstep, voffB); PG8_STAGE(PG8_SA(1, 0), a3, voffA);
            PG8_WAIT_V(8); PG8_WAIT_L(0); PG8_BAR; PG8_MMA(1, 0, At, B0); PG8_MMA(1, 1, At, B1); PG8_BAR; PG8_SCHED;
            } else {
            PG8_LDB(B0, 0, 0); PG8_SCHED; PG8_LDA(At, 0, 0); PG8_STAGE(PG8_SA(1, 1), a1 + hstep, voffA);
            PG8_WAIT_L(8); PG8_BAR; PG8_WAIT_L(0); PG8_MMA(0, 0, At, B0); PG8_BAR; PG8_SCHED;
            PG8_LDB(B1, 0, 1); PG8_STAGE(PG8_SB(0, 0), b2, voffB);
            PG8_BAR; PG8_WAIT_L(0); PG8_MMA(0, 1, At, B1); PG8_BAR;
            PG8_LDA(At, 0, 1); PG8_STAGE(PG8_SA(0, 0), a2, voffA);
            PG8_BAR; PG8_WAIT_L(0); PG8_MMA(1, 0, At, B0); PG8_BAR; PG8_SCHED;
            PG8_STAGE(PG8_SB(0, 1), b2 + hstep, voffB);
            PG8_WAIT_V(6); PG8_BAR; PG8_MMA(1, 1, At, B1); PG8_BAR;
            PG8_LDB(B0, 1, 0); PG8_SCHED; PG8_LDA(At, 1, 0); PG8_STAGE(PG8_SA(0, 1), a2 + hstep, voffA);
            PG8_WAIT_L(8); PG8_BAR; PG8_WAIT_L(0); PG8_MMA(0, 0, At, B0); PG8_BAR; PG8_SCHED;
            PG8_LDB(B1, 1, 1); PG8_STAGE(PG8_SB(1, 0), b3, voffB);
            PG8_BAR; PG8_WAIT_L(0); PG8_MMA(0, 1, At, B1); PG8_BAR;
            PG8_LDA(At, 1, 1); PG8_STAGE(PG8_SA(1, 0), a3, voffA);
            PG8_BAR; PG8_WAIT_L(0); PG8_MMA(1, 0, At, B0); PG8_BAR; PG8_SCHED;
            PG8_STAGE(PG8_SB(1, 1), b3 + hstep, voffB);
            PG8_WAIT_V(6); PG8_BAR; PG8_MMA(1, 1, At, B1); PG8_BAR;
            }
        }
        if constexpr (ALIGN_EPI) { if (wr == 0) PG8_BAR; }
        if constexpr (!Epi::AFTER_DRAIN) { E(acc, cur, ui, wr, wc, fr, fq); S.done(cur); }
        if (!has_next) break;
#pragma unroll
        for (int a = 0; a < 2; ++a)
#pragma unroll
            for (int b = 0; b < 2; ++b)
#pragma unroll
                for (int m = 0; m < 4; ++m)
#pragma unroll
                    for (int n = 0; n < 2; ++n) acc[a][b][m][n] = (f32x4){0.f, 0.f, 0.f, 0.f};
        cur = nxt; cA = nA; cB = nB; ++ui;
        if constexpr (ALIGN_EPI) { if (wr == 1) PG8_BAR; }
    }
    PG8_WAIT_V(0);
    if constexpr (!ALIGN_EPI) { if (wr == 0) PG8_BAR; }
    PG8_BAR;
    if constexpr (Epi::AFTER_DRAIN) { E.fused(acc, cur, wr, wc, fr, fq, lds, wid, lane); S.done(cur); }
#undef PG8_SA
#undef PG8_SB
#undef PG8_STAGE
#undef PG8_LDA
#undef PG8_LDB
#undef PG8_MMA
#undef PG8_WAIT_V
#undef PG8_WAIT_L
#undef PG8_BAR
#undef PG8_SCHED
}
}
constexpr int NB = 8, SEQ = 2048, D = 1024, FF = 4096, M = NB * SEQ;
constexpr int DIN = 3072, CONVD = 512, NH = 8, HD = 64;
constexpr int COL_B = 0, COL_C = 512, COL_U = 1024, COL_Q = 1536, COL_K = 2048, COL_V = 2560;
constexpr int NMOD = 6144;
constexpr float EPS = 1e-6f;
constexpr int NWAVES = 8;
constexpr size_t MiB = 1u << 20;
constexpr size_t WS_CTL = 0, CTL_ZERO_BYTES = 1 * MiB;
constexpr size_t WS_SSQA = 320 * 1024, WS_SSQ2 = 384 * 1024, WS_SB = 512 * 1024;
constexpr size_t WS_CEN = 208 * 1024;
constexpr size_t WS_BAR = 256 * 1024;
constexpr size_t WS_WIN = 2 * MiB, WS_WO = 8 * MiB, WS_W1 = 10 * MiB, WS_W2 = 18 * MiB;
constexpr size_t WS_PROJ = 32 * MiB;
constexpr size_t WS_MIX = 128 * MiB;
constexpr size_t WS_H = 32 * MiB;
constexpr size_t WS_XN = 160 * MiB;
constexpr size_t WS_X1B = 192 * MiB;
constexpr size_t WS_END = 256 * MiB;
constexpr int LDS_BYTES = 147456, MISC_OFF = 131072 + 320;

#define LAS __attribute__((address_space(3)))
typedef unsigned short bf16;
typedef unsigned v4u __attribute__((ext_vector_type(4)));
typedef unsigned v2u __attribute__((ext_vector_type(2)));
typedef float f32x4 __attribute__((ext_vector_type(4)));
typedef float f32x16 __attribute__((ext_vector_type(16)));
typedef short bf16x8 __attribute__((ext_vector_type(8)));
typedef short s16x4 __attribute__((ext_vector_type(4)));
#define LDS_WAIT() asm volatile("s_waitcnt lgkmcnt(0)" ::: "memory")

__device__ __forceinline__ unsigned f2bf(float f) { unsigned u = __builtin_bit_cast(unsigned, f); return (u + 0x7fffu + ((u >> 16) & 1u)) >> 16; }
__device__ __forceinline__ unsigned pk2(float lo, float hi) { return f2bf(lo) | (f2bf(hi) << 16); }
typedef float f32x2_t __attribute__((ext_vector_type(2))); typedef __bf16 bf16x2_t __attribute__((ext_vector_type(2)));
__device__ __forceinline__ unsigned cvtpk(float lo, float hi) { f32x2_t v = {lo, hi}; bf16x2_t b = __builtin_convertvector(v, bf16x2_t); return __builtin_bit_cast(unsigned, b); }
__device__ __forceinline__ float bflo(unsigned w) { return __builtin_bit_cast(float, w << 16); }
__device__ __forceinline__ float bfhi(unsigned w) { return __builtin_bit_cast(float, w & 0xffff0000u); }
__device__ __forceinline__ void unpack8(const v4u r, float (&f)[8]) { f[0] = bflo(r.x); f[1] = bfhi(r.x); f[2] = bflo(r.y); f[3] = bfhi(r.y); f[4] = bflo(r.z); f[5] = bfhi(r.z); f[6] = bflo(r.w); f[7] = bfhi(r.w); }
__device__ __forceinline__ v4u pack8(const float (&f)[8]) { v4u o; o.x = cvtpk(f[0], f[1]); o.y = cvtpk(f[2], f[3]); o.z = cvtpk(f[4], f[5]); o.w = cvtpk(f[6], f[7]); return o; }
__device__ __forceinline__ float wave_sum(float v) {
#pragma unroll
    for (int o = 1; o < 64; o <<= 1) v += __shfl_xor(v, o);
    return v;
}

__device__ __forceinline__ void p0_transpose_item(const float* W, int K, int N, bf16* WT, LAS float* scr, int item, int lane) {
    const int nblk = N / 32, kb = item / nblk, nb = item % nblk, k0 = 64 * kb, n0 = 32 * nb;
    float wv[32];
#pragma unroll
    for (int i = 0; i < 32; ++i) { const int kk = 2 * i + (lane >> 5); wv[i] = __builtin_nontemporal_load(W + (size_t)(k0 + kk) * N + n0 + (lane & 31)); }
#pragma unroll
    for (int i = 0; i < 32; ++i) { const int kk = 2 * i + (lane >> 5); scr[kk * 33 + (lane & 31)] = wv[i]; }
    LDS_WAIT(); asm volatile("" ::: "memory");
    const int c = lane & 7;
#pragma unroll
    for (int j = 0; j < 4; ++j) { const int n = (lane >> 3) + 8 * j; const LAS float* s = scr + (8 * c) * 33 + n;
        v4u o; o.x = pk2(s[0 * 33], s[1 * 33]); o.y = pk2(s[2 * 33], s[3 * 33]); o.z = pk2(s[4 * 33], s[5 * 33]); o.w = pk2(s[6 * 33], s[7 * 33]);
        *(v4u*)(WT + (size_t)(n0 + n) * K + k0 + 8 * c) = o; }
    LDS_WAIT(); asm volatile("" ::: "memory");
}
__device__ __forceinline__ void p0_transpose_wo_item(const float* W, const float* gattn, bf16* WT, LAS float* scr, int item, int lane) {
    constexpr int K = 1024, N = 1024;
    const int nblk = N / 32, kb = item / nblk, nb = item % nblk, k0 = 64 * kb, n0 = 32 * nb;
    float wv[32];
#pragma unroll
    for (int i = 0; i < 32; ++i) { const int kk = 2 * i + (lane >> 5); wv[i] = __builtin_nontemporal_load(W + (size_t)(k0 + kk) * N + n0 + (lane & 31)); }
#pragma unroll
    for (int i = 0; i < 32; ++i) { const int kk = 2 * i + (lane >> 5); float w = wv[i]; if (k0 >= 512) w *= gattn[k0 - 512 + kk]; scr[kk * 33 + (lane & 31)] = w; }
    LDS_WAIT(); asm volatile("" ::: "memory");
    const int c = lane & 7, kd = (k0 + 512) & 1023;
#pragma unroll
    for (int j = 0; j < 4; ++j) { const int n = (lane >> 3) + 8 * j; const LAS float* s = scr + (8 * c) * 33 + n;
        v4u o; o.x = pk2(s[0 * 33], s[1 * 33]); o.y = pk2(s[2 * 33], s[3 * 33]); o.z = pk2(s[4 * 33], s[5 * 33]); o.w = pk2(s[6 * 33], s[7 * 33]);
        *(v4u*)(WT + (size_t)(n0 + n) * K + kd + 8 * c) = o; }
    LDS_WAIT(); asm volatile("" ::: "memory");
}
__device__ __forceinline__ void p0_gemv_item(const float* cvec, const float* wada, float* modacc, int item, int lane) {
    const int jb = item % 96, kc = item / 96, j = 64 * jb + lane, k0 = 64 * kc;
    float s[8], acc[8];
#pragma unroll
    for (int b = 0; b < 8; ++b) { const float v = cvec[b * D + k0 + lane]; s[b] = v / (1.f + __expf(-v)); acc[b] = 0.f; }
    const float* wp = wada + (size_t)k0 * NMOD + j;
#pragma unroll 32
    for (int kk = 0; kk < 64; ++kk) { const float w = __builtin_nontemporal_load(wp + (size_t)kk * NMOD);
#pragma unroll
        for (int b = 0; b < 8; ++b) acc[b] += __shfl(s[b], kk) * w; }
#pragma unroll
    for (int b = 0; b < 8; ++b) atomicAdd(modacc + b * NMOD + j, acc[b]);
}

__device__ __forceinline__ void p1_sb_row(const LAS float* sh, const bf16* W1t, float* sb, int n, int lane) {
    float acc[8];
#pragma unroll
    for (int b = 0; b < 8; ++b) acc[b] = 0.f;
#pragma unroll
    for (int j = 0; j < 4; ++j) { const v2u w = *(const v2u*)(W1t + (size_t)n * D + 256 * j + 4 * lane);
        const float w0 = bflo(w.x), w1 = bfhi(w.x), w2 = bflo(w.y), w3 = bfhi(w.y);
#pragma unroll
        for (int b = 0; b < 8; ++b) { const f32x4 s = *(const LAS f32x4*)(sh + b * D + 256 * j + 4 * lane); acc[b] += (s.x * w0 + s.y * w1) + (s.z * w2 + s.w * w3); } }
#pragma unroll
    for (int b = 0; b < 8; ++b) { const float t = wave_sum(acc[b]); if (lane == 0) sb[b * FF + n] = t; }
}
__device__ __forceinline__ void p1_sb_row1(const LAS float* sh, const bf16* W1t, float* sbrow, int n, int lane) {
    float acc = 0.f;
#pragma unroll
    for (int j = 0; j < 4; ++j) { const v2u w = *(const v2u*)(W1t + (size_t)n * D + 256 * j + 4 * lane); const f32x4 s = *(const LAS f32x4*)(sh + 256 * j + 4 * lane);
        acc += (s.x * bflo(w.x) + s.y * bfhi(w.x)) + (s.z * bflo(w.y) + s.w * bfhi(w.y)); }
    const float t = wave_sum(acc); if (lane == 0) sbrow[n] = t;
}
__device__ __forceinline__ void norm_mod_pass(const float* __restrict__ X, const float* __restrict__ g, const float* __restrict__ modacc, const float* __restrict__ bada, int shift_idx, int scale_idx, bf16* __restrict__ XN, int gw, int NGW, int lane) {
    for (int item = gw; item < M / 8; item += NGW) {
        const int row0 = item * 8, b = row0 / SEQ;
        f32x4 a[4], s[4];
#pragma unroll
        for (int j = 0; j < 4; ++j) { const int col = 4 * lane + 256 * j;
            const f32x4 gg = *(const f32x4*)(g + col);
            const f32x4 sc = *(const f32x4*)(modacc + b * NMOD + scale_idx * D + col) + *(const f32x4*)(bada + scale_idx * D + col);
            s[j] = *(const f32x4*)(modacc + b * NMOD + shift_idx * D + col) + *(const f32x4*)(bada + shift_idx * D + col);
            a[j] = gg * (sc + 1.0f); }
#pragma unroll 4
        for (int r = 0; r < 8; ++r) { const float* xr = X + (size_t)(row0 + r) * D + 4 * lane;
            f32x4 v[4]; float ss = 0.f;
#pragma unroll
            for (int j = 0; j < 4; ++j) { v[j] = __builtin_nontemporal_load((const f32x4*)(xr + 256 * j)); ss += (v[j].x * v[j].x + v[j].y * v[j].y) + (v[j].z * v[j].z + v[j].w * v[j].w); }
            const float rinv = 1.0f / sqrtf(wave_sum(ss) * (1.f / D) + EPS);
            bf16* orow = XN + (size_t)(row0 + r) * D + 4 * lane;
#pragma unroll
            for (int j = 0; j < 4; ++j) { const f32x4 y = v[j] * rinv * a[j] + s[j]; v2u o; o.x = cvtpk(y.x, y.y); o.y = cvtpk(y.z, y.w); *(v2u*)(orow + 256 * j) = o; } }
    }
}

__device__ __forceinline__ void conv_norm_pass(const bf16* __restrict__ PROJ, const float* __restrict__ convw, const float* __restrict__ gconv, bf16* __restrict__ MIX, int gw, int NGW, int lane) {
    const int c = 8 * lane;
    for (int item = gw; item < M / 8; item += NGW) {
        const int row0 = item * 8, t0 = row0 % SEQ;
        float w0[8], w1[8], w2[8], gc[8];
#pragma unroll
        for (int e = 0; e < 8; ++e) { w0[e] = convw[c + e]; w1[e] = convw[CONVD + c + e]; w2[e] = convw[2 * CONVD + c + e]; gc[e] = gconv[c + e]; }
        float cm2[8], cm1[8];
#pragma unroll
        for (int e = 0; e < 8; ++e) { cm2[e] = 0.f; cm1[e] = 0.f; }
        if (t0 != 0) { float a[8], u[8];
            unpack8(*(const v4u*)(PROJ + (size_t)(row0 - 2) * DIN + COL_C + c), a); unpack8(*(const v4u*)(PROJ + (size_t)(row0 - 2) * DIN + COL_U + c), u);
#pragma unroll
            for (int e = 0; e < 8; ++e) cm2[e] = a[e] * u[e];
            unpack8(*(const v4u*)(PROJ + (size_t)(row0 - 1) * DIN + COL_C + c), a); unpack8(*(const v4u*)(PROJ + (size_t)(row0 - 1) * DIN + COL_U + c), u);
#pragma unroll
            for (int e = 0; e < 8; ++e) cm1[e] = a[e] * u[e]; }
#pragma unroll
        for (int r = 0; r < 8; ++r) { const size_t row = (size_t)(row0 + r);
            float bg[8], cgv[8], u[8], y[8];
            unpack8(__builtin_nontemporal_load((const v4u*)(PROJ + row * DIN + COL_B + c)), bg); unpack8(__builtin_nontemporal_load((const v4u*)(PROJ + row * DIN + COL_C + c)), cgv); unpack8(__builtin_nontemporal_load((const v4u*)(PROJ + row * DIN + COL_U + c)), u);
            float ss = 0.f;
#pragma unroll
            for (int e = 0; e < 8; ++e) { const float cu = cgv[e] * u[e]; y[e] = bg[e] * (w0[e] * cm2[e] + w1[e] * cm1[e] + w2[e] * cu); cm2[e] = cm1[e]; cm1[e] = cu; ss += y[e] * y[e]; }
            const float rc = 1.0f / sqrtf(wave_sum(ss) * (1.f / CONVD) + EPS);
#pragma unroll
            for (int e = 0; e < 8; ++e) y[e] = y[e] * rc * gc[e];
            *(v4u*)(MIX + row * D + CONVD + c) = pack8(y); }
    }
}

namespace sba {
constexpr float C2 = 0.125f * 1.4426950408889634f;
constexpr int SLOT = 16384, VOFF = 8192, NSLOT = 5, FLAG_OFF = NSLOT * SLOT, STG_OFF = NSLOT * SLOT + 256;
constexpr float THR_EXIT = 48.0f;
__device__ __forceinline__ int crow(int r, int hi) { return (r & 3) + 8 * (r >> 2) + 4 * hi; }
typedef short v4i16_t __attribute__((ext_vector_type(4)));
__device__ __forceinline__ s16x4 vtr(const LAS unsigned char* p) { return __builtin_bit_cast(s16x4, __builtin_amdgcn_ds_read_tr16_b64_v4i16((LAS v4i16_t*)p)); }

__device__ __forceinline__ void attn_unit(int b, int h, int qb, const bf16* PROJ, const float* gq, const float* gk, bf16* MIX, float* ssq_a, LAS unsigned char* lds) {
    const int wid = __builtin_amdgcn_readfirstlane(threadIdx.x >> 6); const int lane = lane_now(), tid = wid * 64 + lane, r32 = lane & 31, hi = lane >> 5;
    const size_t rowbase = (size_t)b * SEQ; const int q0 = qb * 256;
    const int rb = (wid < 4) ? wid : (wid ^ 1);
    const int key_s = tid >> 3, piece = tid & 7;
    const bf16* Kg = PROJ + (rowbase + key_s) * DIN + COL_K + h * HD + piece * 8;
    const bf16* Vg = PROJ + (rowbase + key_s) * DIN + COL_V + h * HD + piece * 8;
    float gkv[8];
#pragma unroll
    for (int e = 0; e < 8; ++e) gkv[e] = gk[piece * 8 + e];
    const int kdst = piece * 1024 + key_s * 16, vdst = VOFF + (piece >> 2) * 4096 + key_s * 64 + (piece & 3) * 16;
    const int ktw = 4 * qb + (rb >> 1);
    f32x16 o0 = {}, o1 = {}; float carry = 0.f;
    const int vrd = VOFF + ((lane >> 4) & 1) * 32 + (lane & 3) * 8 + (4 * hi + ((lane & 15) >> 2)) * 64;
#define SBA_STAGE(KRAW, VRAW, KT) do { float kf[8]; unpack8(KRAW, kf); float ss_ = 0.f; \
        _Pragma("unroll") for (int e = 0; e < 8; ++e) ss_ += kf[e] * kf[e]; \
        ss_ += __shfl_xor(ss_, 1); ss_ += __shfl_xor(ss_, 2); ss_ += __shfl_xor(ss_, 4); \
        const float rk_ = 1.0f / sqrtf(ss_ * (1.f / HD) + EPS); \
        _Pragma("unroll") for (int e = 0; e < 8; ++e) kf[e] = kf[e] * rk_ * gkv[e]; \
        const int so_ = ((KT) % NSLOT) * SLOT; *(LAS v4u*)(lds + so_ + kdst) = pack8(kf); *(LAS v4u*)(lds + so_ + vdst) = VRAW; } while (0)
    v4u k4[4], v4[4];
#pragma unroll
    for (int j = 0; j < 4; ++j) { k4[j] = *(const v4u*)(Kg + (size_t)(4 * qb + j) * 64 * DIN); v4[j] = *(const v4u*)(Vg + (size_t)(4 * qb + j) * 64 * DIN); }
    bf16x8 qr[4];
    { const bf16* Qw = PROJ + (rowbase + q0 + rb * 32 + r32) * DIN + COL_Q + h * HD + hi * 8;
      float qf[4][8]; float ss = 0.f;
#pragma unroll
      for (int d0 = 0; d0 < 4; ++d0) { unpack8(*(const v4u*)(Qw + d0 * 16), qf[d0]);
#pragma unroll
          for (int e = 0; e < 8; ++e) ss += qf[d0][e] * qf[d0][e]; }
      ss += __shfl_xor(ss, 32);
      const float rq = C2 / sqrtf(ss * (1.f / HD) + EPS);
#pragma unroll
      for (int d0 = 0; d0 < 4; ++d0) { float t[8];
#pragma unroll
          for (int e = 0; e < 8; ++e) t[e] = qf[d0][e] * rq * gq[d0 * 16 + hi * 8 + e];
          qr[d0] = __builtin_bit_cast(bf16x8, pack8(t)); } }
#pragma unroll
    for (int j = 0; j < 4; ++j) SBA_STAGE(k4[j], v4[j], 4 * qb + j);
    v4u kraw = {}, vraw = {};
    if (qb > 0) { kraw = *(const v4u*)(Kg + (size_t)(4 * qb - 1) * 64 * DIN); vraw = *(const v4u*)(Vg + (size_t)(4 * qb - 1) * 64 * DIN); }
    bool wdone = false;
    for (int s = 0; ; ++s) {
        if (s > 0) { const int n = 4 * qb - s;
            if (n >= 0) SBA_STAGE(kraw, vraw, n);
            if (n >= 1) { kraw = *(const v4u*)(Kg + (size_t)(n - 1) * 64 * DIN); vraw = *(const v4u*)(Vg + (size_t)(n - 1) * 64 * DIN); } }
        __syncthreads();
        if (s > 0) {
            const LAS unsigned* fl = (const LAS unsigned*)(lds + FLAG_OFF) + ((s - 1) & 1) * 8;
            const v4u f0 = *(const LAS v4u*)fl, f1 = *(const LAS v4u*)(fl + 4);
            if (__builtin_amdgcn_readfirstlane((f0.x & f0.y) & (f0.z & f0.w) & (f1.x & f1.y) & (f1.z & f1.w)) != 0u) break; }
        const int kt = ktw - s;
        if (kt >= 0 && !wdone) {
            const int slot = (kt % NSLOT) * SLOT;
            const bool diag = (s == 0); const int qrel = (q0 + rb * 32 + r32) - kt * 64;
#pragma unroll
            for (int blk = 1; blk >= 0; --blk) {
                if (blk == 1 && diag && (rb & 1) == 0) continue;
                if (blk == 0 && wdone) break;
                f32x16 p = {};
                const LAS unsigned char* kb = lds + slot + hi * 1024 + r32 * 16 + blk * 512;
#pragma unroll
                for (int d0 = 0; d0 < 4; ++d0) { const bf16x8 b0 = *(const LAS bf16x8*)(kb + d0 * 2048); p = __builtin_amdgcn_mfma_f32_32x32x16_bf16(b0, qr[d0], p, 0, 0, 0); }
                f32x16 sp;
#pragma unroll
                for (int r = 0; r < 16; ++r) {
                    float z = fminf(p[r], 64.f); float t = __builtin_amdgcn_logf(1.0f + __builtin_amdgcn_exp2f(z));
                    if (diag && 32 * blk + crow(r, hi) >= qrel) { t = 0.f; z = -INFINITY; }
                    sp[r] = t; p[r] = z - t; }
                float pairs[4], Bown[4];
#pragma unroll
                for (int j = 0; j < 4; ++j) {
                    const float own = (sp[4 * j] + sp[4 * j + 1]) + (sp[4 * j + 2] + sp[4 * j + 3]);
                    auto rr = __builtin_amdgcn_permlane32_swap(__float_as_uint(own), __float_as_uint(own), false, false);
                    const float glo = __uint_as_float(rr[0]), ghi = __uint_as_float(rr[1]);
                    pairs[j] = glo + ghi; Bown[j] = hi ? 0.f : ghi; }
                { float base = carry;
#pragma unroll
                  for (int j = 3; j >= 0; --j) { Bown[j] += base; base += pairs[j]; }
                  carry = base; }
#pragma unroll
                for (int j = 0; j < 4; ++j) {
                    float rem = Bown[j];
                    p[4 * j + 3] = __builtin_amdgcn_exp2f(p[4 * j + 3] - rem); rem += sp[4 * j + 3];
                    p[4 * j + 2] = __builtin_amdgcn_exp2f(p[4 * j + 2] - rem); rem += sp[4 * j + 2];
                    p[4 * j + 1] = __builtin_amdgcn_exp2f(p[4 * j + 1] - rem); rem += sp[4 * j + 1];
                    p[4 * j + 0] = __builtin_amdgcn_exp2f(p[4 * j + 0] - rem); }
                v4u pw[2];
                pw[0] = (v4u){cvtpk(p[0], p[1]), cvtpk(p[2], p[3]), cvtpk(p[4], p[5]), cvtpk(p[6], p[7])};
                pw[1] = (v4u){cvtpk(p[8], p[9]), cvtpk(p[10], p[11]), cvtpk(p[12], p[13]), cvtpk(p[14], p[15])};
                const LAS unsigned char* vp = lds + slot + vrd + blk * 2048;
#pragma unroll
                for (int ks = 0; ks < 2; ++ks) {
                    const s16x4 l0 = vtr(vp + ks * 1024), h0 = vtr(vp + ks * 1024 + 512), l1 = vtr(vp + 4096 + ks * 1024), h1 = vtr(vp + 4096 + ks * 1024 + 512);
                    const bf16x8 v0 = (bf16x8){l0[0], l0[1], l0[2], l0[3], h0[0], h0[1], h0[2], h0[3]}, v1 = (bf16x8){l1[0], l1[1], l1[2], l1[3], h1[0], h1[1], h1[2], h1[3]};
                    o0 = __builtin_amdgcn_mfma_f32_32x32x16_bf16(__builtin_bit_cast(bf16x8, pw[ks]), v0, o0, 0, 0, 0);
                    o1 = __builtin_amdgcn_mfma_f32_32x32x16_bf16(__builtin_bit_cast(bf16x8, pw[ks]), v1, o1, 0, 0, 0); }
                wdone = __all(carry >= THR_EXIT);
            }
        }
        { const unsigned fin = (wdone || kt <= 0) ? 1u : 0u; if (lane == 0) ((LAS unsigned*)(lds + FLAG_OFF))[(s & 1) * 8 + wid] = fin; }
    }
#undef SBA_STAGE
    { LAS bf16* stg = (LAS bf16*)(lds + STG_OFF + wid * 4096);
#pragma unroll
      for (int r = 0; r < 16; ++r) { const int orow = crow(r, hi); stg[orow * 64 + r32] = (bf16)f2bf(o0[r]); stg[orow * 64 + 32 + r32] = (bf16)f2bf(o1[r]); }
      LDS_WAIT();
      bf16* Ow = MIX + (rowbase + q0 + rb * 32) * D + h * HD;
#pragma unroll
      for (int i = 0; i < 4; ++i) { const int row = i * 8 + (lane >> 3), ch = lane & 7; const v4u v = *(const LAS v4u*)(stg + row * 64 + ch * 8);
          *(v4u*)(Ow + (size_t)row * D + ch * 8) = v;
          float f[8]; unpack8(v, f); float ss = 0.f;
#pragma unroll
          for (int e = 0; e < 8; ++e) ss += f[e] * f[e];
          ss += __shfl_xor(ss, 1); ss += __shfl_xor(ss, 2); ss += __shfl_xor(ss, 4);
          if (ch == 0) atomicAdd(ssq_a + rowbase + q0 + rb * 32 + row, ss); } }
    __syncthreads();
}
}

#define XB_TMO      128
#define XB_XCNT(j)  (256  + 64 * (j))
#define XB_XSUB(j)  (1280 + 64 * (j))
#define XB_XGEN(j)  (2304 + 64 * (j))
#define XB_TOP      3328
#define XB_TOPGEN   3392
#define XCD_BAR_WORDS 3456
#define XB_SPIN_CAP (1u << 18)

__device__ __forceinline__ unsigned xb_ld(unsigned* p)              { return __hip_atomic_load(p, __ATOMIC_RELAXED, __HIP_MEMORY_SCOPE_AGENT); }
__device__ __forceinline__ unsigned xb_add(unsigned* p, unsigned v) { return __hip_atomic_fetch_add(p, v, __ATOMIC_RELAXED, __HIP_MEMORY_SCOPE_AGENT); }
__device__ __forceinline__ unsigned xb_xcc_id() { return (unsigned)__builtin_amdgcn_s_getreg((3 << 11) | 20) & 0xFu; }
#define XB_SPIN(cond, bar) do { unsigned _sp = 0; while (cond) { __builtin_amdgcn_s_sleep(1); \
    if ((++_sp & 255u) == 0u) { if (xb_ld(&(bar)[XB_TMO])) break; if (_sp > XB_SPIN_CAP) { atomicAdd(&(bar)[XB_TMO], 1u); break; } } } } while (0)

struct XcdBarrier {
    unsigned* bar; unsigned x;
    volatile LAS unsigned* st;
};

__device__ __forceinline__ XcdBarrier xcd_barrier_post(unsigned* bar, volatile LAS unsigned* st) {
    XcdBarrier b; b.bar = bar; b.x = xb_xcc_id(); b.st = st;
    if (threadIdx.x == 0) (void)xb_add(&bar[XB_XCNT(b.x)], 1u);
    return b;
}
__device__ __forceinline__ void xcd_barrier_complete(unsigned* bar, unsigned x, unsigned& nloc, unsigned& nx) {
    const unsigned G = gridDim.x * gridDim.y * gridDim.z;
    unsigned sum, cnt, mine, sp = 0u;
    for (;;) {
        sum = 0u; cnt = 0u; mine = 0u;
#pragma unroll
        for (unsigned j = 0; j < 16; ++j) { const unsigned c = xb_ld(&bar[XB_XCNT(j)]); sum += c; cnt += (c > 0u) ? 1u : 0u; mine = (j == x) ? c : mine; }
        if (sum == G) break;
        __builtin_amdgcn_s_sleep(1);
        if ((++sp & 255u) == 0u) { if (xb_ld(&bar[XB_TMO])) break; if (sp > XB_SPIN_CAP) { atomicAdd(&bar[XB_TMO], 1u); break; } }
    }
    nloc = mine > 0u ? mine : 1u; nx = cnt > 0u ? cnt : 1u;
}

__device__ __forceinline__ void xcd_barrier(const XcdBarrier& b, bool local = false) {
    asm volatile("s_waitcnt vmcnt(0)" ::: "memory");
    __syncthreads();
    if (threadIdx.x == 0) {
        unsigned* bar = b.bar;
        __builtin_amdgcn_s_waitcnt(0);
        unsigned nloc = b.st[0], nx = b.st[1];
        if (nloc == 0u) { xcd_barrier_complete(bar, b.x, nloc, nx); b.st[0] = nloc; b.st[1] = nx; }
        const unsigned old = xb_add(&bar[XB_XSUB(b.x)], 1u);
        const unsigned gen = old / nloc;
        if (old + 1u == (gen + 1u) * nloc) {
            if (!local) __builtin_amdgcn_fence(__ATOMIC_RELEASE, "agent");
            asm volatile("s_waitcnt vmcnt(0)" ::: "memory");
            if (!local) {
            const unsigned og = xb_add(&bar[XB_TOP], 1u);
            const unsigned tg = og / nx;
            if (og + 1u == (tg + 1u) * nx) xb_add(&bar[XB_TOPGEN], 1u);
            else XB_SPIN(xb_ld(&bar[XB_TOPGEN]) == tg, bar);
            }
            __builtin_amdgcn_fence(__ATOMIC_ACQUIRE, "agent");
            xb_add(&bar[XB_XGEN(b.x)], 1u);
            asm volatile("s_waitcnt vmcnt(0)" ::: "memory");
        } else {
            __builtin_amdgcn_fence(__ATOMIC_ACQUIRE, "agent");
            XB_SPIN(xb_ld(&bar[XB_XGEN(b.x)]) == gen, bar);
            asm volatile("" ::: "memory");
            asm volatile("s_waitcnt vmcnt(0)" ::: "memory");
        }
    }
    __syncthreads();
}

#ifndef PROBE_DUP
#define PROBE_DUP (-1)
#endif
#ifndef SEAM_LOCAL_ENABLE
#define SEAM_LOCAL_ENABLE 1
#endif
struct Args { const float* in[15]; float* out; unsigned char* ws; int ph_lo, ph_hi, coop, pad; };
constexpr int N_PHASES = 7;
__global__ void __launch_bounds__(NWAVES * 64, 2) mk_fwd(Args args) {
    extern __shared__ __attribute__((aligned(16))) unsigned char lds_raw[];
    LAS unsigned char* lds = (LAS unsigned char*)lds_raw;
    const int wave = __builtin_amdgcn_readfirstlane(threadIdx.x >> 6);
#define tid (wave * 64 + lane_now())
#define lane lane_now()
    const int G = gridDim.x; const int bx = blockIdx.x; const int vcu = (G % 8 == 0) ? (bx % 8) * (G / 8) + bx / 8 : bx;
    const int gw = vcu * NWAVES + wave, NGW = G * NWAVES;
    const float* x = args.in[0]; const float* cvec = args.in[1]; const float* wada = args.in[2]; const float* bada = args.in[3]; const float* g1 = args.in[4];
    const float* win = args.in[5]; const float* convw = args.in[6]; const float* gq = args.in[7]; const float* gk = args.in[8]; const float* gconv = args.in[9];
    const float* gattn = args.in[10]; const float* wout = args.in[11]; const float* g2 = args.in[12]; const float* wff1 = args.in[13]; const float* wff2 = args.in[14];
    float* out = args.out; unsigned char* ws = args.ws;
    float* modacc = (float*)(ws + WS_CTL);
    bf16* Win_t = (bf16*)(ws + WS_WIN); bf16* Wo_t = (bf16*)(ws + WS_WO); bf16* W1_t = (bf16*)(ws + WS_W1); bf16* W2_t = (bf16*)(ws + WS_W2);
    bf16* PROJ = (bf16*)(ws + WS_PROJ); bf16* MIX = (bf16*)(ws + WS_MIX); bf16* HB = (bf16*)(ws + WS_H); bf16* XN = (bf16*)(ws + WS_XN); bf16* X1B = (bf16*)(ws + WS_X1B);
    const int lo = args.ph_lo, hi = args.ph_hi;
    volatile LAS unsigned* MISC = (volatile LAS unsigned*)(lds + MISC_OFF);
    if (tid < 32) MISC[tid] = 0u;
    __syncthreads();
    XcdBarrier bar; bar.bar = (unsigned*)(ws + WS_BAR); bar.x = 0; bar.st = nullptr;
    if (args.coop) bar = xcd_barrier_post((unsigned*)(ws + WS_BAR), MISC + 8);
    unsigned* cen = (unsigned*)(ws + WS_CEN);
    if (args.coop && G == 256 && threadIdx.x == 0) { const unsigned xc = xb_xcc_id(); atomicMax(&cen[vcu >> 5], xc + 1u); atomicMax(&cen[8 + (vcu >> 5)], 16u - xc); }
    int seam_local = 0;
#define IN(k) (lo <= (k) && (k) < hi)
#define SEAM(k) do { if (IN(k) && IN((k) + 1)) { xcd_barrier(bar, (k) > 0 && seam_local != 0); } } while (0)

    float* ssq_a = (float*)(ws + WS_SSQA); float* ssq2 = (float*)(ws + WS_SSQ2); float* sbv = (float*)(ws + WS_SB);
    float* scrf = (float*)(ws + 224 * MiB);
    const int alt = args.pad;
    if (IN(0)) {
        LAS float* scr = (LAS float*)(lds + wave * 16384);
        constexpr int I_IN = (D / 64) * (DIN / 32), I_O = (D / 64) * (D / 32), I_1 = (D / 64) * (FF / 32), I_2 = (FF / 64) * (D / 32), I_G = 16 * 96;
        constexpr int NITEMS = I_G + I_IN + I_O + I_1 + I_2;
        for (int it = gw; it < NITEMS; it += NGW) {
            int r = it;
            if (r < I_G) { p0_gemv_item(cvec, wada, alt ? scrf : modacc, r, lane); continue; } r -= I_G;
            if (r < I_IN) { p0_transpose_item(win, D, DIN, Win_t, scr, r, lane); continue; } r -= I_IN;
            if (r < I_O) { p0_transpose_wo_item(wout, gattn, Wo_t, scr, r, lane); continue; } r -= I_O;
            if (r < I_1) { p0_transpose_item(wff1, D, FF, W1_t, scr, r, lane); continue; } r -= I_1;
            p0_transpose_item(wff2, FF, D, W2_t, scr, r, lane);
        }
    }
    SEAM(0);
    if (args.coop && G == 256) { unsigned ok = 1u;
#pragma unroll
        for (int g_ = 0; g_ < 8; ++g_) { const unsigned a_ = xb_ld(&cen[g_]), b_ = xb_ld(&cen[8 + g_]); ok &= (a_ != 0u && a_ - 1u == 16u - b_) ? 1u : 0u; }
        seam_local = (int)__builtin_amdgcn_readfirstlane(ok) & SEAM_LOCAL_ENABLE; }
    if (IN(1)) { LAS float* sh = (LAS float*)lds;
        if (G == 256) {
            const int bg = vcu >> 5;
            for (int i = tid; i < D; i += NWAVES * 64) sh[i] = modacc[bg * NMOD + 3 * D + i] + bada[3 * D + i];
            __syncthreads();
            for (int n = (vcu & 31) * NWAVES + wave; n < FF; n += 32 * NWAVES) p1_sb_row1(sh, W1_t, sbv + bg * FF, n, lane);
        } else {
        for (int i = tid; i < 8 * D; i += NWAVES * 64) sh[i] = modacc[(i >> 10) * NMOD + 3 * D + (i & 1023)] + bada[3 * D + (i & 1023)];
        __syncthreads();
        for (int n = gw; n < FF; n += NGW) p1_sb_row(sh, W1_t, sbv, n, lane);
        }
        norm_mod_pass(x, g1, modacc, bada, 0, 1, XN, gw, NGW, lane);
        __syncthreads(); }
    SEAM(1);
    if (IN(2)) { pg8::Gemm g{XN, Win_t, M, DIN, D}; pg8::StaticOrder S; S.init(M, DIN, G, bx); pg8::EpiStore<0> E{PROJ, DIN};
        pg8::gemm_phase<pg8::EpiStore<0>, pg8::StaticOrder, true, true>(lds, g, S, E); }
    SEAM(2);
    if (IN(3)) { for (int j = vcu; j < 512; j += G) { const int jj = j & 255, bh = jj >> 2, s = jj & 3, qb = (j < 256) ? s : 7 - s;
            sba::attn_unit(bh >> 3, bh & 7, qb, PROJ, gq, gk, MIX, alt ? scrf : ssq_a, lds); }
        conv_norm_pass(PROJ, convw, gconv, MIX, gw, NGW, lane); }
    SEAM(3);
    if (IN(4)) { pg8::Gemm g{MIX, Wo_t, M, D, D}; pg8::StaticOrder S; S.init(M, D, G, bx); pg8::EpiWo E{x, X1B, XN, modacc, bada, g2, ssq_a, alt ? scrf : ssq2, lds};
        { pg8::Unit u0; if (S.next(0, u0)) E.pre(u0, 0, tid); __syncthreads(); }
        pg8::gemm_phase<pg8::EpiWo, pg8::StaticOrder, false, true>(lds, g, S, E); }
    SEAM(4);
    if (IN(5)) { pg8::Gemm g{XN, W1_t, M, FF, D}; pg8::StaticOrder S; S.init(M, FF, G, bx); pg8::EpiUp E{HB, ssq2, sbv};
        pg8::gemm_phase<pg8::EpiUp, pg8::StaticOrder, true, true>(lds, g, S, E); }
    SEAM(5);
    if (IN(6)) { pg8::Gemm g{HB, W2_t, M, D, FF}; pg8::StaticOrder S; S.init(M, D, G, bx); pg8::EpiResGate E{X1B, alt ? scrf : out, modacc, bada, 5 * D, lds};
        { pg8::Unit u0; if (S.next(0, u0)) E.pre(u0, 0, tid); __syncthreads(); }
        pg8::gemm_phase<pg8::EpiResGate, pg8::StaticOrder, false, true>(lds, g, S, E); }
#undef IN
#undef SEAM
#undef tid
#undef lane
}

#ifndef MK_SPLIT
#define MK_SPLIT 0
#endif
extern "C" void kernel_launch(void* const* d_in, const int* in_sizes, int n_in, void* d_out, int out_size, void* d_ws, size_t ws_size, hipStream_t stream) {
    static int grid = 0;
    if (grid == 0) {
        int dev = 0, cus = 0, per_cu = 0;
        if (n_in != 15 || out_size != M * D || ws_size < WS_END) { fprintf(stderr, "kernel_launch: unexpected shapes\n"); grid = -1; return; }
        hipGetDevice(&dev); hipDeviceGetAttribute(&cus, hipDeviceAttributeMultiprocessorCount, dev);
        if (hipFuncSetAttribute((const void*)mk_fwd, hipFuncAttributeMaxDynamicSharedMemorySize, LDS_BYTES) != hipSuccess) { fprintf(stderr, "kernel_launch: hipFuncSetAttribute failed\n"); grid = -1; return; }
        if (hipOccupancyMaxActiveBlocksPerMultiprocessor(&per_cu, (const void*)mk_fwd, NWAVES * 64, LDS_BYTES) != hipSuccess || per_cu < 1) { fprintf(stderr, "kernel_launch: the occupancy query reports %d resident workgroups per CU for this kernel; a grid-wide barrier needs at least 1; nothing launched\n", per_cu); grid = -1; return; }
        (void)hipGetLastError();
        if (cus != 256) { fprintf(stderr, "kernel_launch: built for a 256-CU device (one 256x256 unit per workgroup in the N=1024 GEMM phases); got %d CUs\n", cus); grid = -1; return; }
        grid = cus * (per_cu < 1 ? per_cu : 1);
    }
    if (grid < 0) return;
    (void)hipMemsetAsync((char*)d_ws + WS_CTL, 0, CTL_ZERO_BYTES, stream);
    Args a{};
    for (int i = 0; i < 15; ++i) a.in[i] = (const float*)d_in[i];
    a.out = (float*)d_out; a.ws = (unsigned char*)d_ws;
#if MK_SPLIT
    for (int p = 0; p < N_PHASES; ++p) { a.ph_lo = p; a.ph_hi = p + 1; a.coop = 0; a.pad = 0; hipLaunchKernelGGL(mk_fwd, dim3(grid), dim3(NWAVES * 64), LDS_BYTES, stream, a);
        if (p == PROBE_DUP) { a.pad = 1; hipLaunchKernelGGL(mk_fwd, dim3(grid), dim3(NWAVES * 64), LDS_BYTES, stream, a); } }
#else
    a.ph_lo = 0; a.ph_hi = N_PHASES; a.coop = 1;
    void* kargs[] = {&a};
    hipError_t e = hipLaunchCooperativeKernel((const void*)mk_fwd, dim3(grid), dim3(NWAVES * 64), kargs, LDS_BYTES, stream);
    if (e != hipSuccess) fprintf(stderr, "kernel_launch: cooperative launch failed: %s (grid %d)\n", hipGetErrorString(e), grid);
#endif
}
```

```cpp
#include <hip/hip_runtime.h>
#include <hip/hip_cooperative_groups.h>
#include <cstdio>
#include <cstdint>
namespace cg = cooperative_groups;
__device__ __forceinline__ int lane_now() { int l; asm volatile("v_mbcnt_lo_u32_b32 %0, -1, 0\n\tv_mbcnt_hi_u32_b32 %0, -1, %0" : "=v"(l)); return l; }
namespace pg8 {
#define PG8_LAS __attribute__((address_space(3)))
typedef unsigned short bf16_t;
typedef short bf16x8 __attribute__((ext_vector_type(8)));
typedef float f32x4 __attribute__((ext_vector_type(4)));
typedef unsigned u32x4 __attribute__((ext_vector_type(4)));
constexpr int BM = 256, BK = 64, HALF = 128, HTB = HALF * BK * 2  , STAGE_BYTES = 8 * HTB, NXCD = 8, WGM = 8;

__host__ __device__ __forceinline__ int lds_byte(int r, int c) { const int st = (r >> 4) * 2 + (c >> 5), rr = r & 15, cc = c & 31, ob = rr * 64 + cc * 2; return st * 1024 + (ob ^ (((ob >> 9) & 1) << 5)); }
__host__ __device__ __forceinline__ void stage_rc(int b, int& R, int& C) { const int st = b / 1024, sb = b % 1024, swz = sb ^ (((sb >> 9) & 1) << 5); R = (st >> 1) * 16 + swz / 64; C = (st & 1) * 32 + (swz % 64) / 2; }
__host__ __device__ __forceinline__ int perm32(int rho) { const int n = rho >> 4, i = rho & 15; return 8 * (i >> 2) + 4 * n + (i & 3); }

struct Unit { int pm, pn; };
struct Gemm { const bf16_t* A; const bf16_t* Bt; int M, N, K; };

struct StaticOrder {
    int nM, nN, nwg, G, c;
    __host__ __device__ void init(int M, int N, int G_, int c_) { nM = M / BM; nN = N / BM; nwg = nM * nN; G = G_; c = c_; }
    __host__ __device__ bool next(int i, Unit& u) const {
        const long L = (long)i * G + c; if (L >= nwg) return false;
        int wgid = (int)L; { const int q = nwg / NXCD, r = nwg % NXCD, xcd = wgid % NXCD, off = wgid / NXCD; wgid = (xcd < r ? xcd * (q + 1) : r * (q + 1) + (xcd - r) * q) + off; }
        const int nig = WGM * nN, gid = wgid / nig, fm = gid * WGM, gsz = (nM - fm) < WGM ? (nM - fm) : WGM;
        u.pm = fm + ((wgid % nig) % gsz); u.pn = (wgid % nig) / gsz; return true;
    }
    __device__ __forceinline__ void a_ready(const Unit&) const {}
    __device__ __forceinline__ void done(const Unit&) const {}
};

__device__ __forceinline__ unsigned cvt_pk_bf16(float lo, float hi) { unsigned r; asm volatile("v_cvt_pk_bf16_f32 %0, %1, %2" : "=v"(r) : "v"(lo), "v"(hi)); return r; }
typedef float f32x2 __attribute__((ext_vector_type(2)));
__device__ __forceinline__ f32x2 gelu_pk(f32x2 v) {
    const f32x2 av = __builtin_elementwise_abs(v), d = av * 0.2316418882f + 1.0f;
    f32x2 t; t.x = __builtin_amdgcn_rcpf(d.x); t.y = __builtin_amdgcn_rcpf(d.y);
    f32x2 q = t * 0.5307027145f + (-0.7265760135f); q = q * t + 0.7107068705f; q = q * t + (-0.142248368f); q = q * t + 0.127414796f; q = q * t;
    const f32x2 s = (v * v) * (-0.72134752044f);
    f32x2 e; e.x = __builtin_amdgcn_exp2f(s.x); e.y = __builtin_amdgcn_exp2f(s.y);
    const f32x2 m = v * (q * e), r = v - m;
    f32x2 o; o.x = v.x < 0.f ? m.x : r.x; o.y = v.y < 0.f ? m.y : r.y; return o;
}

template <int ACT  > struct EpiBf16 {
    static constexpr bool PERM = true, AFTER_DRAIN = false; static_assert(ACT == 0 || ACT == 1, "EpiBf16: ACT is 0 (none) or 1 (gelu_pk)");
    bf16_t* O; int ldc; const float* bias; int split_cols; size_t split_stride; float scale0;
    __device__ __forceinline__ void operator()(const f32x4 (&acc)[2][2][4][2], const Unit& u, int wr, int wc, int fr, int fq) const {
        const int row0 = u.pm * BM + wr * 64 + fr; int colt = u.pn * BM; bf16_t* base = O;
        float sc = 1.f; if (split_cols) { const int t = colt / split_cols; base += (size_t)t * split_stride; colt -= t * split_cols; if (t == 0) sc = scale0; }
        const int col0 = colt + wc * 32 + 8 * fq, bcol0 = u.pn * BM + wc * 32 + 8 * fq;
        f32x4 bv[2][2];
#pragma unroll
        for (int bj = 0; bj < 2; ++bj)
#pragma unroll
            for (int n = 0; n < 2; ++n) bv[bj][n] = bias ? *(const f32x4*)(bias + bcol0 + bj * HALF + 4 * n) : (f32x4){0.f, 0.f, 0.f, 0.f};
#pragma unroll
        for (int ai = 0; ai < 2; ++ai)
#pragma unroll
            for (int m = 0; m < 4; ++m) { bf16_t* rowp = base + (size_t)(row0 + ai * HALF + m * 16) * ldc + col0;
#pragma unroll
                for (int bj = 0; bj < 2; ++bj) { f32x4 v0 = acc[ai][bj][m][0] + bv[bj][0], v1 = acc[ai][bj][m][1] + bv[bj][1];
                    if (ACT == 1) { f32x2 a = gelu_pk((f32x2){v0[0], v0[1]}), b = gelu_pk((f32x2){v0[2], v0[3]}), c = gelu_pk((f32x2){v1[0], v1[1]}), d = gelu_pk((f32x2){v1[2], v1[3]});
                        v0 = (f32x4){a.x, a.y, b.x, b.y}; v1 = (f32x4){c.x, c.y, d.x, d.y}; }
                    v0 = v0 * sc; v1 = v1 * sc; u32x4 w; w.x = cvt_pk_bf16(v0[0], v0[1]); w.y = cvt_pk_bf16(v0[2], v0[3]); w.z = cvt_pk_bf16(v1[0], v1[1]); w.w = cvt_pk_bf16(v1[2], v1[3]);
                    *(u32x4*)(rowp + bj * HALF) = w; } }
    }
};
template <int ACT> struct EpiStore {
    static constexpr bool PERM = true, AFTER_DRAIN = false, MIDK = false, SCALE = false;
    bf16_t* O; int ldc;
    __device__ __forceinline__ void operator()(const f32x4 (&acc)[2][2][4][2], const Unit& u, int ui, int wr, int wc, int fr, int fq) const {
        const int row0 = u.pm * BM + wr * 64 + fr; const int col0 = u.pn * BM + wc * 32 + 8 * fq;
#pragma unroll
        for (int ai = 0; ai < 2; ++ai)
#pragma unroll
            for (int m = 0; m < 4; ++m) { bf16_t* rowp = O + (size_t)(row0 + ai * HALF + m * 16) * ldc + col0;
#pragma unroll
                for (int bj = 0; bj < 2; ++bj) { f32x4 v0 = acc[ai][bj][m][0], v1 = acc[ai][bj][m][1];
                    if (ACT == 2) {
#pragma unroll
                        for (int e = 0; e < 4; ++e) { float a = fmaxf(v0[e], 0.f), b = fmaxf(v1[e], 0.f); v0[e] = a * a; v1[e] = b * b; } }
                    u32x4 w; w.x = cvt_pk_bf16(v0[0], v0[1]); w.y = cvt_pk_bf16(v0[2], v0[3]); w.z = cvt_pk_bf16(v1[0], v1[1]); w.w = cvt_pk_bf16(v1[2], v1[3]);
                    *(u32x4*)(rowp + bj * HALF) = w; } }
    }
};
#define PG8_TAB(lds, par) ((PG8_LAS float*)((lds) + 132096 + (par) * 3072))
struct EpiResGate {
    static constexpr bool PERM = false, AFTER_DRAIN = false, MIDK = false, SCALE = false;
    const bf16_t* base; float* out; const float* modacc; const float* bada; int goff; PG8_LAS unsigned char* lds;
    __device__ __forceinline__ void pre(const Unit& u, int ui, int tid_) const { int tid = tid_; asm volatile("" : "+v"(tid));
        if (tid < 256) { const int c = goff + u.pn * BM + tid; PG8_TAB(lds, 0)[256 + tid] = modacc[(u.pm >> 3) * 6144 + c] + bada[c]; }
    }
    __device__ __forceinline__ void operator()(const f32x4 (&acc)[2][2][4][2], const Unit& u, int ui, int wr, int wc, int fr, int fq) const {
        typedef unsigned u32x2v __attribute__((ext_vector_type(2)));
        const PG8_LAS float* tab = PG8_TAB(lds, 0) + 256;
        const int cl0 = wc * 32 + 4 * fq; const size_t off0 = (size_t)(u.pm * BM + wr * 64 + fr) * 1024 + u.pn * BM + cl0;
        u32x2v xb[2][8];
#define PG8_LDX(g, buf) do { _Pragma("unroll") for (int q_ = 0; q_ < 8; ++q_) xb[buf][q_] = *(const u32x2v*)(base + off0 + (size_t)((q_ >> 2) * HALF + (q_ & 3) * 16) * 1024 + ((g) >> 1) * HALF + ((g) & 1) * 16); } while (0)
        PG8_LDX(0, 0);
#pragma unroll
        for (int g = 0; g < 4; ++g) { const int bj = g >> 1, n = g & 1;
            if (g < 3) PG8_LDX(g + 1, (g + 1) & 1);
            const f32x4 gv = *(const PG8_LAS f32x4*)(tab + cl0 + bj * HALF + n * 16);
#pragma unroll
            for (int q = 0; q < 8; ++q) { const int ai = q >> 2, m = q & 3; const u32x2v w = xb[g & 1][q];
                const f32x4 bs = {__builtin_bit_cast(float, w.x << 16), __builtin_bit_cast(float, w.x & 0xffff0000u), __builtin_bit_cast(float, w.y << 16), __builtin_bit_cast(float, w.y & 0xffff0000u)};
                __builtin_nontemporal_store(bs + gv * acc[ai][bj][m][n], (f32x4*)(out + off0 + (size_t)(ai * HALF + m * 16) * 1024 + bj * HALF + n * 16)); } }
#undef PG8_LDX
    }
};
struct EpiWo {
    static constexpr bool PERM = false, AFTER_DRAIN = false, MIDK = false, SCALE = true;
    const float* base; bf16_t* x1b; bf16_t* xn; const float* modacc; const float* bada; const float* g2; const float* ssq_a; float* ssq2; PG8_LAS unsigned char* lds;
    __device__ __forceinline__ void pre(const Unit& u, int ui, int tid_) const { int tid = tid_; asm volatile("" : "+v"(tid));
        PG8_LAS float* tab = PG8_TAB(lds, 0);
        if (tid < 256) { const int c = u.pn * BM + tid, b = u.pm >> 3;
            tab[256 + tid] = modacc[b * 6144 + 2048 + c] + bada[2048 + c];
            tab[512 + tid] = g2[c] * (modacc[b * 6144 + 4096 + c] + bada[4096 + c] + 1.0f); }
        else tab[tid - 256] = 1.0f / sqrtf(ssq_a[u.pm * BM + tid - 256] * (1.f / 512.f) + 1e-6f);
    }
    __device__ __forceinline__ void mid(f32x4 (&acc)[2][2][4][2], const Unit& u, int ui, int wr, int wc, int fr, int fq) const {
        const PG8_LAS float* tab = PG8_TAB(lds, 0); int frp = fr; asm volatile("" : "+v"(frp));
#pragma unroll
        for (int ai = 0; ai < 2; ++ai)
#pragma unroll
            for (int m = 0; m < 4; ++m) { const float ra = tab[ai * HALF + wr * 64 + m * 16 + frp];
#pragma unroll
                for (int bj = 0; bj < 2; ++bj)
#pragma unroll
                    for (int n = 0; n < 2; ++n) acc[ai][bj][m][n] *= ra; }
    }
    __device__ __forceinline__ void operator()(const f32x4 (&acc)[2][2][4][2], const Unit& u, int ui, int wr, int wc, int fr, int fq) const {
        typedef unsigned u32x2v __attribute__((ext_vector_type(2)));
        const PG8_LAS float* tab = PG8_TAB(lds, 0);
        const int cl0 = wc * 32 + 4 * fq; const int rowb = u.pm * BM + wr * 64 + fr; const size_t off0 = (size_t)rowb * 1024 + u.pn * BM + cl0;
        float ss[8];
#pragma unroll
        for (int q = 0; q < 8; ++q) ss[q] = 0.f;
        f32x4 xb[2][4];
#define PG8_LDX(g, buf) do { _Pragma("unroll") for (int q_ = 0; q_ < 4; ++q_) xb[buf][q_] = __builtin_nontemporal_load((const f32x4*)(base + off0 + (size_t)(((g) & 1) * HALF + q_ * 16) * 1024 + ((g) >> 2) * HALF + (((g) >> 1) & 1) * 16)); } while (0)
        PG8_LDX(0, 0);
#pragma unroll
        for (int g = 0; g < 8; ++g) { const int bj = g >> 2, n = (g >> 1) & 1, ai = g & 1;
            if (g < 7) PG8_LDX(g + 1, (g + 1) & 1);
            const f32x4 gv = *(const PG8_LAS f32x4*)(tab + 256 + cl0 + bj * HALF + n * 16), av = *(const PG8_LAS f32x4*)(tab + 512 + cl0 + bj * HALF + n * 16);
#pragma unroll
            for (int m = 0; m < 4; ++m) { const size_t off = off0 + (size_t)(ai * HALF + m * 16) * 1024 + bj * HALF + n * 16;
                const f32x4 x1 = xb[g & 1][m] + gv * acc[ai][bj][m][n];
                u32x2v w; w.x = cvt_pk_bf16(x1[0], x1[1]); w.y = cvt_pk_bf16(x1[2], x1[3]);
                *(u32x2v*)(x1b + off) = w;
                ss[ai * 4 + m] += (x1[0] * x1[0] + x1[1] * x1[1]) + (x1[2] * x1[2] + x1[3] * x1[3]);
                const f32x4 y = x1 * av; w.x = cvt_pk_bf16(y[0], y[1]); w.y = cvt_pk_bf16(y[2], y[3]);
                *(u32x2v*)(xn + off) = w; } }
#undef PG8_LDX
#pragma unroll
        for (int q = 0; q < 8; ++q) { float s = ss[q]; s += __shfl_xor(s, 16); s += __shfl_xor(s, 32);
            if (fq == 0) atomicAdd(ssq2 + rowb + (q >> 2) * HALF + (q & 3) * 16, s); }
    }
};
struct EpiUp {
    static constexpr bool PERM = true, AFTER_DRAIN = false, MIDK = false, SCALE = false;
    bf16_t* O; const float* ssq2; const float* sb;
    __device__ __forceinline__ void operator()(const f32x4 (&acc)[2][2][4][2], const Unit& u, int ui, int wr, int wc, int fr, int fq) const {
        const int b = u.pm >> 3; const int row0 = u.pm * BM + wr * 64 + fr; const int col0 = u.pn * BM + wc * 32 + 8 * fq;
        f32x4 sv[2][2]; float rv[2][4];
#pragma unroll
        for (int ai = 0; ai < 2; ++ai)
#pragma unroll
            for (int m = 0; m < 4; ++m) rv[ai][m] = ssq2[row0 + ai * HALF + m * 16];
#pragma unroll
        for (int bj = 0; bj < 2; ++bj)
#pragma unroll
            for (int n = 0; n < 2; ++n) sv[bj][n] = *(const f32x4*)(sb + b * 4096 + col0 + bj * HALF + 4 * n);
#pragma unroll
        for (int ai = 0; ai < 2; ++ai)
#pragma unroll
            for (int m = 0; m < 4; ++m) { const int row = row0 + ai * HALF + m * 16; const float rinv = 1.0f / sqrtf(rv[ai][m] * (1.f / 1024.f) + 1e-6f);
                bf16_t* rowp = O + (size_t)row * 4096 + col0;
#pragma unroll
                for (int bj = 0; bj < 2; ++bj) { f32x4 v0 = acc[ai][bj][m][0] * rinv + sv[bj][0], v1 = acc[ai][bj][m][1] * rinv + sv[bj][1];
#pragma unroll
                    for (int e = 0; e < 4; ++e) { const float a = fmaxf(v0[e], 0.f), c = fmaxf(v1[e], 0.f); v0[e] = a * a; v1[e] = c * c; }
                    u32x4 w; w.x = cvt_pk_bf16(v0[0], v0[1]); w.y = cvt_pk_bf16(v0[2], v0[3]); w.z = cvt_pk_bf16(v1[0], v1[1]); w.w = cvt_pk_bf16(v1[2], v1[3]);
                    *(u32x4*)(rowp + bj * HALF) = w; } }
    }
};
template <class Epi, class Sched, bool ALIGN_EPI = false, bool SP2 = false>
__device__ __forceinline__ void gemm_phase(PG8_LAS unsigned char* lds, const Gemm g, const Sched& S, const Epi& E) {
    const int wid = __builtin_amdgcn_readfirstlane(threadIdx.x >> 6), lane = lane_now(), tid = wid * 64 + lane, wr = wid >> 2, wc = wid & 3, fr = lane & 15, fq = lane >> 4;
    const int K = g.K, nt = K / BK;
    unsigned voffA[2], voffB[2];
#pragma unroll
    for (int i = 0; i < 2; ++i) { int R, C; stage_rc(tid * 16 + i * 8192, R, C); const int Rb = Epi::PERM ? ((R & ~31) + perm32(R & 31)) : R;
        voffA[i] = (unsigned)(R * K + C) * 2u; voffB[i] = (unsigned)(Rb * K + C) * 2u; }
    const size_t kstep = (size_t)(BK * 2);
    const size_t hstep = (size_t)HALF * K * 2;
    const size_t tstep = 2 * hstep;
    const unsigned ldsw = (unsigned)wid * 1024u;
    const int aoff = lds_byte(wr * 64 + fr, fq * 8), boff = lds_byte(wc * 32 + fr, fq * 8);
#define PG8_SA(b, h) (((b) * 2 + (h)) * HTB)
#define PG8_SB(b, h) ((4 + (b) * 2 + (h)) * HTB)
#define PG8_STAGE(bufoff, gbase, voff) do { _Pragma("unroll") for (int _i = 0; _i < 2; ++_i) \
        __builtin_amdgcn_global_load_lds((const unsigned*)((const char*)(gbase) + (voff)[_i]), (PG8_LAS unsigned*)(lds + (bufoff) + ldsw + _i * 8192), 16, 0, 0); } while (0)
#define PG8_LDA(dst, b, h) do { _Pragma("unroll") for (int m = 0; m < 4; ++m) _Pragma("unroll") for (int k = 0; k < 2; ++k) dst[m][k] = *(const PG8_LAS bf16x8*)(lds + PG8_SA(b, h) + aoff + m * 2048 + k * 1024); } while (0)
#define PG8_LDB(dst, b, h) do { _Pragma("unroll") for (int n = 0; n < 2; ++n) _Pragma("unroll") for (int k = 0; k < 2; ++k) dst[n][k] = *(const PG8_LAS bf16x8*)(lds + PG8_SB(b, h) + boff + n * 2048 + k * 1024); } while (0)
#define PG8_MMA(ai, bj, At, Bt) do { __builtin_amdgcn_s_setprio(1); _Pragma("unroll") for (int m = 0; m < 4; ++m) _Pragma("unroll") for (int n = 0; n < 2; ++n) _Pragma("unroll") for (int k = 0; k < 2; ++k) \
        acc[ai][bj][m][n] = __builtin_amdgcn_mfma_f32_16x16x32_bf16(Bt[n][k], At[m][k], acc[ai][bj][m][n], 0, 0, 0); __builtin_amdgcn_s_setprio(0); } while (0)
#define PG8_WAIT_V(n) asm volatile("s_waitcnt vmcnt(" #n ")" ::: "memory")
#define PG8_WAIT_L(n) asm volatile("s_waitcnt lgkmcnt(" #n ")" ::: "memory")
#define PG8_BAR __builtin_amdgcn_s_barrier()
#define PG8_SCHED __builtin_amdgcn_sched_barrier(0)
    Unit cur, nxt; int ui = 0;
    if (!S.next(0, cur)) return;
    f32x4 acc[2][2][4][2];
#pragma unroll
    for (int a = 0; a < 2; ++a)
#pragma unroll
        for (int b = 0; b < 2; ++b)
#pragma unroll
            for (int m = 0; m < 4; ++m)
#pragma unroll
                for (int n = 0; n < 2; ++n) acc[a][b][m][n] = (f32x4){0.f, 0.f, 0.f, 0.f};
    bf16x8 At[4][2], B0[2][2], B1[2][2];
    const char* cA = (const char*)g.A + (size_t)cur.pm * tstep; const char* cB = (const char*)g.Bt + (size_t)cur.pn * tstep;
    S.a_ready(cur);
    if constexpr (SP2) {
        PG8_STAGE(PG8_SB(0, 0), cB, voffB); PG8_STAGE(PG8_SB(0, 1), cB + hstep, voffB); PG8_STAGE(PG8_SA(0, 0), cA, voffA); PG8_STAGE(PG8_SA(0, 1), cA + hstep, voffA);
        if (wr == 1) PG8_BAR;
        PG8_WAIT_V(2); PG8_BAR;
        PG8_STAGE(PG8_SB(1, 0), cB + kstep, voffB); PG8_STAGE(PG8_SA(1, 0), cA + kstep, voffA); PG8_STAGE(PG8_SB(1, 1), cB + hstep + kstep, voffB);
        PG8_WAIT_V(6); PG8_BAR;
    } else {
        PG8_STAGE(PG8_SB(0, 0), cB, voffB); PG8_STAGE(PG8_SA(0, 0), cA, voffA); PG8_STAGE(PG8_SB(0, 1), cB + hstep, voffB); PG8_STAGE(PG8_SA(0, 1), cA + hstep, voffA);
        if (wr == 1) PG8_BAR;
        PG8_WAIT_V(4); PG8_BAR;
        PG8_STAGE(PG8_SB(1, 0), cB + kstep, voffB); PG8_STAGE(PG8_SA(1, 0), cA + kstep, voffA); PG8_STAGE(PG8_SB(1, 1), cB + hstep + kstep, voffB);
        PG8_WAIT_V(6); PG8_BAR;
    }
    for (;;) {
        const bool has_next = S.next(ui + 1, nxt);
        const char* nA = has_next ? (const char*)g.A + (size_t)nxt.pm * tstep : cA; const char* nB = has_next ? (const char*)g.Bt + (size_t)nxt.pn * tstep : cB;
        for (int t = 0; t < nt; t += 2) {
            const bool last = (t == nt - 2);
            const char* a1 = cA + (size_t)(t + 1) * kstep;
            const char* a2 = last ? nA : cA + (size_t)(t + 2) * kstep; const char* b2 = last ? nB : cB + (size_t)(t + 2) * kstep;
            const char* a3 = a2 + kstep; const char* b3 = b2 + kstep;
            if (last && has_next) S.a_ready(nxt);
            if constexpr (Epi::SCALE) { if (t == nt / 2) E.mid(acc, cur, ui, wr, wc, fr, fq); }
            if constexpr (SP2) {
            PG8_LDB(B0, 0, 0); PG8_LDB(B1, 0, 1); PG8_SCHED; PG8_LDA(At, 0, 0); PG8_STAGE(PG8_SA(1, 1), a1 + hstep, voffA);
            PG8_WAIT_V(8); PG8_WAIT_L(0); PG8_BAR; PG8_MMA(0, 0, At, B0); PG8_MMA(0, 1, At, B1); PG8_BAR; PG8_SCHED;
            PG8_LDA(At, 0, 1); PG8_STAGE(PG8_SB(0, 0), b2, voffB); PG8_STAGE(PG8_SB(0, 1), b2 + hstep, voffB); PG8_STAGE(PG8_SA(0, 0), a2, voffA);
            PG8_WAIT_V(8); PG8_WAIT_L(0); PG8_BAR; PG8_MMA(1, 0, At, B0); PG8_MMA(1, 1, At, B1); PG8_BAR; PG8_SCHED;
            PG8_LDB(B0, 1, 0); PG8_LDB(B1, 1, 1); PG8_SCHED; PG8_LDA(At, 1, 0); PG8_STAGE(PG8_SA(0, 1), a2 + hstep, voffA);
            PG8_WAIT_V(8); PG8_WAIT_L(0); PG8_BAR; PG8_MMA(0, 0, At, B0); PG8_MMA(0, 1, At, B1); PG8_BAR; PG8_SCHED;
            PG8_LDA(At, 1, 1); PG8_STAGE(PG8_SB(1, 0), b3, voffB); PG8_STAGE(PG8_SB(1, 1), b3 + hstep, voffB); PG8_STAGE(PG8_SA(1, 0), a3, voffA);
            PG8_WAIT_V(8); PG8_WAIT_L(0); PG8_BAR; PG8_MMA(1, 0, At, B0); PG8_MMA(1, 1, At, B1); PG8_BAR; PG8_SCHED;
            } else {
            PG8_LDB(B0, 0, 0); PG8_SCHED; PG8_LDA(At, 0, 0); PG8_STAGE(PG8_SA(1, 1), a1 + hstep, voffA);
            PG8_WAIT_L(8); PG8_BAR; PG8_WAIT_L(0); PG8_MMA(0, 0, At, B0); PG8_BAR; PG8_SCHED;
            PG8_LDB(B1, 0, 1); PG8_STAGE(PG8_SB(0, 0), b2, voffB);
            PG8_BAR; PG8_WAIT_L(0); PG8_MMA(0, 1, At, B1); PG8_BAR;
            PG8_LDA(At, 0, 1); PG8_STAGE(PG8_SA(0, 0), a2, voffA);
            PG8_BAR; PG8_WAIT_L(0); PG8_MMA(1, 0, At, B0); PG8_BAR; PG8_SCHED;
            PG8_STAGE(PG8_SB(0, 1), b2 + hstep, voffB);
            PG8_WAIT_V(6); PG8_BAR; PG8_MMA(1, 1, At, B1); PG8_BAR;
            PG8_LDB(B0, 1, 0); PG8_SCHED; PG8_LDA(At, 1, 0); PG8_STAGE(PG8_SA(0, 1), a2 + hstep, voffA);
            PG8_WAIT_L(8); PG8_BAR; PG8_WAIT_L(0); PG8_MMA(0, 0, At, B0); PG8_BAR; PG8_SCHED;
            PG8_LDB(B1, 1, 1); PG8_STAGE(PG8_SB(1, 0), b3, voffB);
            PG8_BAR; PG8_WAIT_L(0); PG8_MMA(0, 1, At, B1); PG8_BAR;
            PG8_LDA(At, 1, 1); PG8_STAGE(PG8_SA(1, 0), a3, voffA);
            PG8_BAR; PG8_WAIT_L(0); PG8_MMA(1, 0, At, B0); PG8_BAR; PG8_SCHED;
            PG8_STAGE(PG8_SB(1, 1), b3 + hstep, voffB);
            PG8_WAIT_V(6); PG8_BAR; PG8_MMA(1, 1, At, B1); PG8_BAR;
            }
        }
        if constexpr (ALIGN_EPI) { if (wr == 0) PG8_BAR; }
        if constexpr (!Epi::AFTER_DRAIN) { E(acc, cur, ui, wr, wc, fr, fq); S.done(cur); }
        if (!has_next) break;
#pragma unroll
        for (int a = 0; a < 2; ++a)
#pragma unroll
            for (int b = 0; b < 2; ++b)
#pragma unroll
                for (int m = 0; m < 4; ++m)
#pragma unroll
                    for (int n = 0; n < 2; ++n) acc[a][b][m][n] = (f32x4){0.f, 0.f, 0.f, 0.f};
        cur = nxt; cA = nA; cB = nB; ++ui;
        if constexpr (ALIGN_EPI) { if (wr == 1) PG8_BAR; }
    }
    PG8_WAIT_V(0);
    if constexpr (!ALIGN_EPI) { if (wr == 0) PG8_BAR; }
    PG8_BAR;
    if constexpr (Epi::AFTER_DRAIN) { E.fused(acc, cur, wr, wc, fr, fq, lds, wid, lane); S.done(cur); }
#undef PG8_SA
#undef PG8_SB
#undef PG8_STAGE
#undef PG8_LDA
#undef PG8_LDB
#undef PG8_MMA
#undef PG8_WAIT_V
#undef PG8_WAIT_L
#undef PG8_BAR
#undef PG8_SCHED
}
}
constexpr int NB = 8, SEQ = 2048, D = 1024, FF = 4096, M = NB * SEQ;
constexpr int DIN = 3072, CONVD = 512, NH = 8, HD = 64;
constexpr int COL_B = 0, COL_C = 512, COL_U = 1024, COL_Q = 1536, COL_K = 2048, COL_V = 2560;
constexpr int NMOD = 6144;
constexpr float EPS = 1e-6f;
constexpr int NWAVES = 8;
constexpr size_t MiB = 1u << 20;
constexpr size_t WS_CTL = 0, CTL_ZERO_BYTES = 1 * MiB;
constexpr size_t WS_SSQA = 320 * 1024, WS_SSQ2 = 384 * 1024, WS_SB = 512 * 1024;
constexpr size_t WS_CEN = 208 * 1024;
constexpr size_t WS_BAR = 256 * 1024;
constexpr size_t WS_WIN = 2 * MiB, WS_WO = 8 * MiB, WS_W1 = 10 * MiB, WS_W2 = 18 * MiB;
constexpr size_t WS_PROJ = 32 * MiB;
constexpr size_t WS_MIX = 128 * MiB;
constexpr size_t WS_H = 32 * MiB;
constexpr size_t WS_XN = 160 * MiB;
constexpr size_t WS_X1B = 192 * MiB;
constexpr size_t WS_END = 256 * MiB;
constexpr int LDS_BYTES = 147456, MISC_OFF = 131072 + 320;

#define LAS __attribute__((address_space(3)))
typedef unsigned short bf16;
typedef unsigned v4u __attribute__((ext_vector_type(4)));
typedef unsigned v2u __attribute__((ext_vector_type(2)));
typedef float f32x4 __attribute__((ext_vector_type(4)));
typedef float f32x16 __attribute__((ext_vector_type(16)));
typedef short bf16x8 __attribute__((ext_vector_type(8)));
typedef short s16x4 __attribute__((ext_vector_type(4)));
#define LDS_WAIT() asm volatile("s_waitcnt lgkmcnt(0)" ::: "memory")

__device__ __forceinline__ unsigned f2bf(float f) { unsigned u = __builtin_bit_cast(unsigned, f); return (u + 0x7fffu + ((u >> 16) & 1u)) >> 16; }
__device__ __forceinline__ unsigned pk2(float lo, float hi) { return f2bf(lo) | (f2bf(hi) << 16); }
typedef float f32x2_t __attribute__((ext_vector_type(2))); typedef __bf16 bf16x2_t __attribute__((ext_vector_type(2)));
__device__ __forceinline__ unsigned cvtpk(float lo, float hi) { f32x2_t v = {lo, hi}; bf16x2_t b = __builtin_convertvector(v, bf16x2_t); return __builtin_bit_cast(unsigned, b); }
__device__ __forceinline__ float bflo(unsigned w) { return __builtin_bit_cast(float, w << 16); }
__device__ __forceinline__ float bfhi(unsigned w) { return __builtin_bit_cast(float, w & 0xffff0000u); }
__device__ __forceinline__ void unpack8(const v4u r, float (&f)[8]) { f[0] = bflo(r.x); f[1] = bfhi(r.x); f[2] = bflo(r.y); f[3] = bfhi(r.y); f[4] = bflo(r.z); f[5] = bfhi(r.z); f[6] = bflo(r.w); f[7] = bfhi(r.w); }
__device__ __forceinline__ v4u pack8(const float (&f)[8]) { v4u o; o.x = cvtpk(f[0], f[1]); o.y = cvtpk(f[2], f[3]); o.z = cvtpk(f[4], f[5]); o.w = cvtpk(f[6], f[7]); return o; }
__device__ __forceinline__ float wave_sum(float v) {
#pragma unroll
    for (int o = 1; o < 64; o <<= 1) v += __shfl_xor(v, o);
    return v;
}

__device__ __forceinline__ void p0_transpose_item(const float* W, int K, int N, bf16* WT, LAS float* scr, int item, int lane) {
    const int nblk = N / 32, kb = item / nblk, nb = item % nblk, k0 = 64 * kb, n0 = 32 * nb;
    float wv[32];
#pragma unroll
    for (int i = 0; i < 32; ++i) { const int kk = 2 * i + (lane >> 5); wv[i] = __builtin_nontemporal_load(W + (size_t)(k0 + kk) * N + n0 + (lane & 31)); }
#pragma unroll
    for (int i = 0; i < 32; ++i) { const int kk = 2 * i + (lane >> 5); scr[kk * 33 + (lane & 31)] = wv[i]; }
    LDS_WAIT(); asm volatile("" ::: "memory");
    const int c = lane & 7;
#pragma unroll
    for (int j = 0; j < 4; ++j) { const int n = (lane >> 3) + 8 * j; const LAS float* s = scr + (8 * c) * 33 + n;
        v4u o; o.x = pk2(s[0 * 33], s[1 * 33]); o.y = pk2(s[2 * 33], s[3 * 33]); o.z = pk2(s[4 * 33], s[5 * 33]); o.w = pk2(s[6 * 33], s[7 * 33]);
        *(v4u*)(WT + (size_t)(n0 + n) * K + k0 + 8 * c) = o; }
    LDS_WAIT(); asm volatile("" ::: "memory");
}
__device__ __forceinline__ void p0_transpose_wo_item(const float* W, const float* gattn, bf16* WT, LAS float* scr, int item, int lane) {
    constexpr int K = 1024, N = 1024;
    const int nblk = N / 32, kb = item / nblk, nb = item % nblk, k0 = 64 * kb, n0 = 32 * nb;
    float wv[32];
#pragma unroll
    for (int i = 0; i < 32; ++i) { const int kk = 2 * i + (lane >> 5); wv[i] = __builtin_nontemporal_load(W + (size_t)(k0 + kk) * N + n0 + (lane & 31)); }
#pragma unroll
    for (int i = 0; i < 32; ++i) { const int kk = 2 * i + (lane >> 5); float w = wv[i]; if (k0 >= 512) w *= gattn[k0 - 512 + kk]; scr[kk * 33 + (lane & 31)] = w; }
    LDS_WAIT(); asm volatile("" ::: "memory");
    const int c = lane & 7, kd = (k0 + 512) & 1023;
#pragma unroll
    for (int j = 0; j < 4; ++j) { const int n = (lane >> 3) + 8 * j; const LAS float* s = scr + (8 * c) * 33 + n;
        v4u o; o.x = pk2(s[0 * 33], s[1 * 33]); o.y = pk2(s[2 * 33], s[3 * 33]); o.z = pk2(s[4 * 33], s[5 * 33]); o.w = pk2(s[6 * 33], s[7 * 33]);
        *(v4u*)(WT + (size_t)(n0 + n) * K + kd + 8 * c) = o; }
    LDS_WAIT(); asm volatile("" ::: "memory");
}
__device__ __forceinline__ void p0_gemv_item(const float* cvec, const float* wada, float* modacc, int item, int lane) {
    const int jb = item % 96, kc = item / 96, j = 64 * jb + lane, k0 = 64 * kc;
    float s[8], acc[8];
#pragma unroll
    for (int b = 0; b < 8; ++b) { const float v = cvec[b * D + k0 + lane]; s[b] = v / (1.f + __expf(-v)); acc[b] = 0.f; }
    const float* wp = wada + (size_t)k0 * NMOD + j;
#pragma unroll 32
    for (int kk = 0; kk < 64; ++kk) { const float w = __builtin_nontemporal_load(wp + (size_t)kk * NMOD);
#pragma unroll
        for (int b = 0; b < 8; ++b) acc[b] += __shfl(s[b], kk) * w; }
#pragma unroll
    for (int b = 0; b < 8; ++b) atomicAdd(modacc + b * NMOD + j, acc[b]);
}

__device__ __forceinline__ void p1_sb_row(const LAS float* sh, const bf16* W1t, float* sb, int n, int lane) {
    float acc[8];
#pragma unroll
    for (int b = 0; b < 8; ++b) acc[b] = 0.f;
#pragma unroll
    for (int j = 0; j < 4; ++j) { const v2u w = *(const v2u*)(W1t + (size_t)n * D + 256 * j + 4 * lane);
        const float w0 = bflo(w.x), w1 = bfhi(w.x), w2 = bflo(w.y), w3 = bfhi(w.y);
#pragma unroll
        for (int b = 0; b < 8; ++b) { const f32x4 s = *(const LAS f32x4*)(sh + b * D + 256 * j + 4 * lane); acc[b] += (s.x * w0 + s.y * w1) + (s.z * w2 + s.w * w3); } }
#pragma unroll
    for (int b = 0; b < 8; ++b) { const float t = wave_sum(acc[b]); if (lane == 0) sb[b * FF + n] = t; }
}
__device__ __forceinline__ void p1_sb_row1(const LAS float* sh, const bf16* W1t, float* sbrow, int n, int lane) {
    float acc = 0.f;
#pragma unroll
    for (int j = 0; j < 4; ++j) { const v2u w = *(const v2u*)(W1t + (size_t)n * D + 256 * j + 4 * lane); const f32x4 s = *(const LAS f32x4*)(sh + 256 * j + 4 * lane);
        acc += (s.x * bflo(w.x) + s.y * bfhi(w.x)) + (s.z * bflo(w.y) + s.w * bfhi(w.y)); }
    const float t = wave_sum(acc); if (lane == 0) sbrow[n] = t;
}
__device__ __forceinline__ void norm_mod_pass(const float* __restrict__ X, const float* __restrict__ g, const float* __restrict__ modacc, const float* __restrict__ bada, int shift_idx, int scale_idx, bf16* __restrict__ XN, int gw, int NGW, int lane) {
    for (int item = gw; item < M / 8; item += NGW) {
        const int row0 = item * 8, b = row0 / SEQ;
        f32x4 a[4], s[4];
#pragma unroll
        for (int j = 0; j < 4; ++j) { const int col = 4 * lane + 256 * j;
            const f32x4 gg = *(const f32x4*)(g + col);
            const f32x4 sc = *(const f32x4*)(modacc + b * NMOD + scale_idx * D + col) + *(const f32x4*)(bada + scale_idx * D + col);
            s[j] = *(const f32x4*)(modacc + b * NMOD + shift_idx * D + col) + *(const f32x4*)(bada + shift_idx * D + col);
            a[j] = gg * (sc + 1.0f); }
#pragma unroll 4
        for (int r = 0; r < 8; ++r) { const float* xr = X + (size_t)(row0 + r) * D + 4 * lane;
            f32x4 v[4]; float ss = 0.f;
#pragma unroll
            for (int j = 0; j < 4; ++j) { v[j] = __builtin_nontemporal_load((const f32x4*)(xr + 256 * j)); ss += (v[j].x * v[j].x + v[j].y * v[j].y) + (v[j].z * v[j].z + v[j].w * v[j].w); }
            const float rinv = 1.0f / sqrtf(wave_sum(ss) * (1.f / D) + EPS);
            bf16* orow = XN + (size_t)(row0 + r) * D + 4 * lane;
#pragma unroll
            for (int j = 0; j < 4; ++j) { const f32x4 y = v[j] * rinv * a[j] + s[j]; v2u o; o.x = cvtpk(y.x, y.y); o.y = cvtpk(y.z, y.w); *(v2u*)(orow + 256 * j) = o; } }
    }
}

__device__ __forceinline__ void conv_norm_pass(const bf16* __restrict__ PROJ, const float* __restrict__ convw, const float* __restrict__ gconv, bf16* __restrict__ MIX, int gw, int NGW, int lane) {
    const int c = 8 * lane;
    for (int item = gw; item < M / 8; item += NGW) {
        const int row0 = item * 8, t0 = row0 % SEQ;
        float w0[8], w1[8], w2[8], gc[8];
#pragma unroll
        for (int e = 0; e < 8; ++e) { w0[e] = convw[c + e]; w1[e] = convw[CONVD + c + e]; w2[e] = convw[2 * CONVD + c + e]; gc[e] = gconv[c + e]; }
        float cm2[8], cm1[8];
#pragma unroll
        for (int e = 0; e < 8; ++e) { cm2[e] = 0.f; cm1[e] = 0.f; }
        if (t0 != 0) { float a[8], u[8];
            unpack8(*(const v4u*)(PROJ + (size_t)(row0 - 2) * DIN + COL_C + c), a); unpack8(*(const v4u*)(PROJ + (size_t)(row0 - 2) * DIN + COL_U + c), u);
#pragma unroll
            for (int e = 0; e < 8; ++e) cm2[e] = a[e] * u[e];
            unpack8(*(const v4u*)(PROJ + (size_t)(row0 - 1) * DIN + COL_C + c), a); unpack8(*(const v4u*)(PROJ + (size_t)(row0 - 1) * DIN + COL_U + c), u);
#pragma unroll
            for (int e = 0; e < 8; ++e) cm1[e] = a[e] * u[e]; }
#pragma unroll
        for (int r = 0; r < 8; ++r) { const size_t row = (size_t)(row0 + r);
            float bg[8], cgv[8], u[8], y[8];
            unpack8(__builtin_nontemporal_load((const v4u*)(PROJ + row * DIN + COL_B + c)), bg); unpack8(__builtin_nontemporal_load((const v4u*)(PROJ + row * DIN + COL_C + c)), cgv); unpack8(__builtin_nontemporal_load((const v4u*)(PROJ + row * DIN + COL_U + c)), u);
            float ss = 0.f;
#pragma unroll
            for (int e = 0; e < 8; ++e) { const float cu = cgv[e] * u[e]; y[e] = bg[e] * (w0[e] * cm2[e] + w1[e] * cm1[e] + w2[e] * cu); cm2[e] = cm1[e]; cm1[e] = cu; ss += y[e] * y[e]; }
            const float rc = 1.0f / sqrtf(wave_sum(ss) * (1.f / CONVD) + EPS);
#pragma unroll
            for (int e = 0; e < 8; ++e) y[e] = y[e] * rc * gc[e];
            *(v4u*)(MIX + row * D + CONVD + c) = pack8(y); }
    }
}

namespace sba {
constexpr float C2 = 0.125f * 1.4426950408889634f;
constexpr int SLOT = 16384, VOFF = 8192, NSLOT = 5, FLAG_OFF = NSLOT * SLOT, STG_OFF = NSLOT * SLOT + 256;
constexpr float THR_EXIT = 48.0f;
__device__ __forceinline__ int crow(int r, int hi) { return (r & 3) + 8 * (r >> 2) + 4 * hi; }
typedef short v4i16_t __attribute__((ext_vector_type(4)));
__device__ __forceinline__ s16x4 vtr(const LAS unsigned char* p) { return __builtin_bit_cast(s16x4, __builtin_amdgcn_ds_read_tr16_b64_v4i16((LAS v4i16_t*)p)); }

__device__ __forceinline__ void attn_unit(int b, int h, int qb, const bf16* PROJ, const float* gq, const float* gk, bf16* MIX, float* ssq_a, LAS unsigned char* lds) {
    const int wid = __builtin_amdgcn_readfirstlane(threadIdx.x >> 6); const int lane = lane_now(), tid = wid * 64 + lane, r32 = lane & 31, hi = lane >> 5;
    const size_t rowbase = (size_t)b * SEQ; const int q0 = qb * 256;
    const int rb = (wid < 4) ? wid : (wid ^ 1);
    const int key_s = tid >> 3, piece = tid & 7;
    const bf16* Kg = PROJ + (rowbase + key_s) * DIN + COL_K + h * HD + piece * 8;
    const bf16* Vg = PROJ + (rowbase + key_s) * DIN + COL_V + h * HD + piece * 8;
    float gkv[8];
#pragma unroll
    for (int e = 0; e < 8; ++e) gkv[e] = gk[piece * 8 + e];
    const int kdst = piece * 1024 + key_s * 16, vdst = VOFF + (piece >> 2) * 4096 + key_s * 64 + (piece & 3) * 16;
    const int ktw = 4 * qb + (rb >> 1);
    f32x16 o0 = {}, o1 = {}; float carry = 0.f;
    const int vrd = VOFF + ((lane >> 4) & 1) * 32 + (lane & 3) * 8 + (4 * hi + ((lane & 15) >> 2)) * 64;
#define SBA_STAGE(KRAW, VRAW, KT) do { float kf[8]; unpack8(KRAW, kf); float ss_ = 0.f; \
        _Pragma("unroll") for (int e = 0; e < 8; ++e) ss_ += kf[e] * kf[e]; \
        ss_ += __shfl_xor(ss_, 1); ss_ += __shfl_xor(ss_, 2); ss_ += __shfl_xor(ss_, 4); \
        const float rk_ = __builtin_amdgcn_rsqf(ss_ * (1.f / HD) + EPS); \
        _Pragma("unroll") for (int e = 0; e < 8; ++e) kf[e] = kf[e] * rk_ * gkv[e]; \
        const int so_ = ((KT) % NSLOT) * SLOT; *(LAS v4u*)(lds + so_ + kdst) = pack8(kf); *(LAS v4u*)(lds + so_ + vdst) = VRAW; } while (0)
    v4u k4[4], v4[4];
#pragma unroll
    for (int j = 0; j < 4; ++j) { k4[j] = *(const v4u*)(Kg + (size_t)(4 * qb + j) * 64 * DIN); v4[j] = *(const v4u*)(Vg + (size_t)(4 * qb + j) * 64 * DIN); }
    bf16x8 qr[4];
    { const bf16* Qw = PROJ + (rowbase + q0 + rb * 32 + r32) * DIN + COL_Q + h * HD + hi * 8;
      float qf[4][8]; float ss = 0.f;
#pragma unroll
      for (int d0 = 0; d0 < 4; ++d0) { unpack8(*(const v4u*)(Qw + d0 * 16), qf[d0]);
#pragma unroll
          for (int e = 0; e < 8; ++e) ss += qf[d0][e] * qf[d0][e]; }
      ss += __shfl_xor(ss, 32);
      const float rq = C2 * __builtin_amdgcn_rsqf(ss * (1.f / HD) + EPS);
#pragma unroll
      for (int d0 = 0; d0 < 4; ++d0) { float t[8];
#pragma unroll
          for (int e = 0; e < 8; ++e) t[e] = qf[d0][e] * rq * gq[d0 * 16 + hi * 8 + e];
          qr[d0] = __builtin_bit_cast(bf16x8, pack8(t)); } }
#pragma unroll
    for (int j = 0; j < 4; ++j) SBA_STAGE(k4[j], v4[j], 4 * qb + j);
    v4u kraw = {}, vraw = {};
    if (qb > 0) { kraw = *(const v4u*)(Kg + (size_t)(4 * qb - 1) * 64 * DIN); vraw = *(const v4u*)(Vg + (size_t)(4 * qb - 1) * 64 * DIN); }
    bool wdone = false;
    for (int s = 0; ; ++s) {
        if (s > 0) { const int n = 4 * qb - s;
            if (n >= 0) SBA_STAGE(kraw, vraw, n);
            if (n >= 1) { kraw = *(const v4u*)(Kg + (size_t)(n - 1) * 64 * DIN); vraw = *(const v4u*)(Vg + (size_t)(n - 1) * 64 * DIN); } }
        __syncthreads();
        if (s > 0) {
            const LAS unsigned* fl = (const LAS unsigned*)(lds + FLAG_OFF) + ((s - 1) & 1) * 8;
            const v4u f0 = *(const LAS v4u*)fl, f1 = *(const LAS v4u*)(fl + 4);
            if (__builtin_amdgcn_readfirstlane((f0.x & f0.y) & (f0.z & f0.w) & (f1.x & f1.y) & (f1.z & f1.w)) != 0u) break; }
        const int kt = ktw - s;
        if (kt >= 0 && !wdone) {
            const int slot = (kt % NSLOT) * SLOT;
            const bool diag = (s == 0); const int qrel = (q0 + rb * 32 + r32) - kt * 64;
#pragma unroll
            for (int blk = 1; blk >= 0; --blk) {
                if (blk == 1 && diag && (rb & 1) == 0) continue;
                if (blk == 0 && wdone) break;
                f32x16 p = {};
                const LAS unsigned char* kb = lds + slot + hi * 1024 + r32 * 16 + blk * 512;
#pragma unroll
                for (int d0 = 0; d0 < 4; ++d0) { const bf16x8 b0 = *(const LAS bf16x8*)(kb + d0 * 2048); p = __builtin_amdgcn_mfma_f32_32x32x16_bf16(b0, qr[d0], p, 0, 0, 0); }
                f32x16 sp;
#pragma unroll
                for (int r = 0; r < 16; ++r) {
                    float z = __builtin_amdgcn_fmed3f(p[r], 64.f, -INFINITY); float t = __builtin_amdgcn_logf(1.0f + __builtin_amdgcn_exp2f(z));
                    if (diag && 32 * blk + crow(r, hi) >= qrel) { t = 0.f; z = -INFINITY; }
                    sp[r] = t; p[r] = z; }
                float pairs[4], Bown[4];
#pragma unroll
                for (int j = 0; j < 4; ++j) {
                    const float own = (sp[4 * j] + sp[4 * j + 1]) + (sp[4 * j + 2] + sp[4 * j + 3]);
                    auto rr = __builtin_amdgcn_permlane32_swap(__float_as_uint(own), __float_as_uint(own), false, false);
                    const float glo = __uint_as_float(rr[0]), ghi = __uint_as_float(rr[1]);
                    pairs[j] = glo + ghi; Bown[j] = hi ? 0.f : ghi; }
                { float base = carry;
#pragma unroll
                  for (int j = 3; j >= 0; --j) { Bown[j] += base; base += pairs[j]; }
                  carry = base; }
#pragma unroll
                for (int j = 0; j < 4; ++j) {
                    float rem = Bown[j] + sp[4 * j + 3];
                    p[4 * j + 3] = __builtin_amdgcn_exp2f(p[4 * j + 3] - rem); rem += sp[4 * j + 2];
                    p[4 * j + 2] = __builtin_amdgcn_exp2f(p[4 * j + 2] - rem); rem += sp[4 * j + 1];
                    p[4 * j + 1] = __builtin_amdgcn_exp2f(p[4 * j + 1] - rem); rem += sp[4 * j + 0];
                    p[4 * j + 0] = __builtin_amdgcn_exp2f(p[4 * j + 0] - rem); }
                v4u pw[2];
                pw[0] = (v4u){cvtpk(p[0], p[1]), cvtpk(p[2], p[3]), cvtpk(p[4], p[5]), cvtpk(p[6], p[7])};
                pw[1] = (v4u){cvtpk(p[8], p[9]), cvtpk(p[10], p[11]), cvtpk(p[12], p[13]), cvtpk(p[14], p[15])};
                const LAS unsigned char* vp = lds + slot + vrd + blk * 2048;
#pragma unroll
                for (int ks = 0; ks < 2; ++ks) {
                    const s16x4 l0 = vtr(vp + ks * 1024), h0 = vtr(vp + ks * 1024 + 512), l1 = vtr(vp + 4096 + ks * 1024), h1 = vtr(vp + 4096 + ks * 1024 + 512);
                    const bf16x8 v0 = (bf16x8){l0[0], l0[1], l0[2], l0[3], h0[0], h0[1], h0[2], h0[3]}, v1 = (bf16x8){l1[0], l1[1], l1[2], l1[3], h1[0], h1[1], h1[2], h1[3]};
                    o0 = __builtin_amdgcn_mfma_f32_32x32x16_bf16(__builtin_bit_cast(bf16x8, pw[ks]), v0, o0, 0, 0, 0);
                    o1 = __builtin_amdgcn_mfma_f32_32x32x16_bf16(__builtin_bit_cast(bf16x8, pw[ks]), v1, o1, 0, 0, 0); }
                wdone = __all(carry >= THR_EXIT);
            }
        }
        { const unsigned fin = (wdone || kt <= 0) ? 1u : 0u; if (lane == 0) ((LAS unsigned*)(lds + FLAG_OFF))[(s & 1) * 8 + wid] = fin; }
    }
#undef SBA_STAGE
    { LAS bf16* stg = (LAS bf16*)(lds + STG_OFF + wid * 4096);
#pragma unroll
      for (int r = 0; r < 16; ++r) { const int orow = crow(r, hi); stg[orow * 64 + r32] = (bf16)f2bf(o0[r]); stg[orow * 64 + 32 + r32] = (bf16)f2bf(o1[r]); }
      LDS_WAIT();
      bf16* Ow = MIX + (rowbase + q0 + rb * 32) * D + h * HD;
#pragma unroll
      for (int i = 0; i < 4; ++i) { const int row = i * 8 + (lane >> 3), ch = lane & 7; const v4u v = *(const LAS v4u*)(stg + row * 64 + ch * 8);
          *(v4u*)(Ow + (size_t)row * D + ch * 8) = v;
          float f[8]; unpack8(v, f); float ss = 0.f;
#pragma unroll
          for (int e = 0; e < 8; ++e) ss += f[e] * f[e];
          ss += __shfl_xor(ss, 1); ss += __shfl_xor(ss, 2); ss += __shfl_xor(ss, 4);
          if (ch == 0) atomicAdd(ssq_a + rowbase + q0 + rb * 32 + row, ss); } }
    __syncthreads();
}
}

#define XB_TMO      128
#define XB_XCNT(j)  (256  + 64 * (j))
#define XB_XSUB(j)  (1280 + 64 * (j))
#define XB_XGEN(j)  (2304 + 64 * (j))
#define XB_TOP      3328
#define XB_TOPGEN   3392
#define XCD_BAR_WORDS 3456
#define XB_SPIN_CAP (1u << 18)

__device__ __forceinline__ unsigned xb_ld(unsigned* p)              { return __hip_atomic_load(p, __ATOMIC_RELAXED, __HIP_MEMORY_SCOPE_AGENT); }
__device__ __forceinline__ unsigned xb_add(unsigned* p, unsigned v) { return __hip_atomic_fetch_add(p, v, __ATOMIC_RELAXED, __HIP_MEMORY_SCOPE_AGENT); }
__device__ __forceinline__ unsigned xb_xcc_id() { return (unsigned)__builtin_amdgcn_s_getreg((3 << 11) | 20) & 0xFu; }
#define XB_SPIN(cond, bar) do { unsigned _sp = 0; while (cond) { __builtin_amdgcn_s_sleep(1); \
    if ((++_sp & 255u) == 0u) { if (xb_ld(&(bar)[XB_TMO])) break; if (_sp > XB_SPIN_CAP) { atomicAdd(&(bar)[XB_TMO], 1u); break; } } } } while (0)

struct XcdBarrier {
    unsigned* bar; unsigned x;
    volatile LAS unsigned* st;
};

__device__ __forceinline__ XcdBarrier xcd_barrier_post(unsigned* bar, volatile LAS unsigned* st) {
    XcdBarrier b; b.bar = bar; b.x = xb_xcc_id(); b.st = st;
    if (threadIdx.x == 0) (void)xb_add(&bar[XB_XCNT(b.x)], 1u);
    return b;
}
__device__ __forceinline__ void xcd_barrier_complete(unsigned* bar, unsigned x, unsigned& nloc, unsigned& nx) {
    const unsigned G = gridDim.x * gridDim.y * gridDim.z;
    unsigned sum, cnt, mine, sp = 0u;
    for (;;) {
        sum = 0u; cnt = 0u; mine = 0u;
#pragma unroll
        for (unsigned j = 0; j < 16; ++j) { const unsigned c = xb_ld(&bar[XB_XCNT(j)]); sum += c; cnt += (c > 0u) ? 1u : 0u; mine = (j == x) ? c : mine; }
        if (sum == G) break;
        __builtin_amdgcn_s_sleep(1);
        if ((++sp & 255u) == 0u) { if (xb_ld(&bar[XB_TMO])) break; if (sp > XB_SPIN_CAP) { atomicAdd(&bar[XB_TMO], 1u); break; } }
    }
    nloc = mine > 0u ? mine : 1u; nx = cnt > 0u ? cnt : 1u;
}

__device__ __forceinline__ void xcd_barrier(const XcdBarrier& b, bool local = false) {
    asm volatile("s_waitcnt vmcnt(0)" ::: "memory");
    __syncthreads();
    if (threadIdx.x == 0) {
        unsigned* bar = b.bar;
        __builtin_amdgcn_s_waitcnt(0);
        unsigned nloc = b.st[0], nx = b.st[1];
        if (nloc == 0u) { xcd_barrier_complete(bar, b.x, nloc, nx); b.st[0] = nloc; b.st[1] = nx; }
        const unsigned old = xb_add(&bar[XB_XSUB(b.x)], 1u);
        const unsigned gen = old / nloc;
        if (old + 1u == (gen + 1u) * nloc) {
            if (!local) __builtin_amdgcn_fence(__ATOMIC_RELEASE, "agent");
            asm volatile("s_waitcnt vmcnt(0)" ::: "memory");
            if (!local) {
            const unsigned og = xb_add(&bar[XB_TOP], 1u);
            const unsigned tg = og / nx;
            if (og + 1u == (tg + 1u) * nx) xb_add(&bar[XB_TOPGEN], 1u);
            else XB_SPIN(xb_ld(&bar[XB_TOPGEN]) == tg, bar);
            }
            __builtin_amdgcn_fence(__ATOMIC_ACQUIRE, "agent");
            xb_add(&bar[XB_XGEN(b.x)], 1u);
            asm volatile("s_waitcnt vmcnt(0)" ::: "memory");
        } else {
            __builtin_amdgcn_fence(__ATOMIC_ACQUIRE, "agent");
            XB_SPIN(xb_ld(&bar[XB_XGEN(b.x)]) == gen, bar);
            asm volatile("" ::: "memory");
            asm volatile("s_waitcnt vmcnt(0)" ::: "memory");
        }
    }
    __syncthreads();
}

#ifndef PROBE_DUP
#define PROBE_DUP (-1)
#endif
#ifndef SEAM_LOCAL_ENABLE
#define SEAM_LOCAL_ENABLE 1
#endif
struct Args { const float* in[15]; float* out; unsigned char* ws; int ph_lo, ph_hi, coop, pad; };
constexpr int N_PHASES = 7;
__global__ void __launch_bounds__(NWAVES * 64, 2) mk_fwd(Args args) {
    extern __shared__ __attribute__((aligned(16))) unsigned char lds_raw[];
    LAS unsigned char* lds = (LAS unsigned char*)lds_raw;
    const int wave = __builtin_amdgcn_readfirstlane(threadIdx.x >> 6);
#define tid (wave * 64 + lane_now())
#define lane lane_now()
    const int G = gridDim.x; const int bx = blockIdx.x; const int vcu = (G % 8 == 0) ? (bx % 8) * (G / 8) + bx / 8 : bx;
    const int gw = vcu * NWAVES + wave, NGW = G * NWAVES;
    const float* x = args.in[0]; const float* cvec = args.in[1]; const float* wada = args.in[2]; const float* bada = args.in[3]; const float* g1 = args.in[4];
    const float* win = args.in[5]; const float* convw = args.in[6]; const float* gq = args.in[7]; const float* gk = args.in[8]; const float* gconv = args.in[9];
    const float* gattn = args.in[10]; const float* wout = args.in[11]; const float* g2 = args.in[12]; const float* wff1 = args.in[13]; const float* wff2 = args.in[14];
    float* out = args.out; unsigned char* ws = args.ws;
    float* modacc = (float*)(ws + WS_CTL);
    bf16* Win_t = (bf16*)(ws + WS_WIN); bf16* Wo_t = (bf16*)(ws + WS_WO); bf16* W1_t = (bf16*)(ws + WS_W1); bf16* W2_t = (bf16*)(ws + WS_W2);
    bf16* PROJ = (bf16*)(ws + WS_PROJ); bf16* MIX = (bf16*)(ws + WS_MIX); bf16* HB = (bf16*)(ws + WS_H); bf16* XN = (bf16*)(ws + WS_XN); bf16* X1B = (bf16*)(ws + WS_X1B);
    const int lo = args.ph_lo, hi = args.ph_hi;
    volatile LAS unsigned* MISC = (volatile LAS unsigned*)(lds + MISC_OFF);
    if (tid < 32) MISC[tid] = 0u;
    __syncthreads();
    XcdBarrier bar; bar.bar = (unsigned*)(ws + WS_BAR); bar.x = 0; bar.st = nullptr;
    if (args.coop) bar = xcd_barrier_post((unsigned*)(ws + WS_BAR), MISC + 8);
    unsigned* cen = (unsigned*)(ws + WS_CEN);
    if (args.coop && G == 256 && threadIdx.x == 0) { const unsigned xc = xb_xcc_id(); atomicMax(&cen[vcu >> 5], xc + 1u); atomicMax(&cen[8 + (vcu >> 5)], 16u - xc); }
    int seam_local = 0;
#define IN(k) (lo <= (k) && (k) < hi)
#define SEAM(k) do { if (IN(k) && IN((k) + 1)) { xcd_barrier(bar, (k) > 0 && seam_local != 0); } } while (0)

    float* ssq_a = (float*)(ws + WS_SSQA); float* ssq2 = (float*)(ws + WS_SSQ2); float* sbv = (float*)(ws + WS_SB);
    float* scrf = (float*)(ws + 224 * MiB);
    const int alt = args.pad;
    if (IN(0)) {
        LAS float* scr = (LAS float*)(lds + wave * 16384);
        constexpr int I_IN = (D / 64) * (DIN / 32), I_O = (D / 64) * (D / 32), I_1 = (D / 64) * (FF / 32), I_2 = (FF / 64) * (D / 32), I_G = 16 * 96;
        constexpr int NITEMS = I_G + I_IN + I_O + I_1 + I_2;
        for (int it = gw; it < NITEMS; it += NGW) {
            int r = it;
            if (r < I_G) { p0_gemv_item(cvec, wada, alt ? scrf : modacc, r, lane); continue; } r -= I_G;
            if (r < I_IN) { p0_transpose_item(win, D, DIN, Win_t, scr, r, lane); continue; } r -= I_IN;
            if (r < I_O) { p0_transpose_wo_item(wout, gattn, Wo_t, scr, r, lane); continue; } r -= I_O;
            if (r < I_1) { p0_transpose_item(wff1, D, FF, W1_t, scr, r, lane); continue; } r -= I_1;
            p0_transpose_item(wff2, FF, D, W2_t, scr, r, lane);
        }
    }
    SEAM(0);
    if (args.coop && G == 256) { unsigned ok = 1u;
#pragma unroll
        for (int g_ = 0; g_ < 8; ++g_) { const unsigned a_ = xb_ld(&cen[g_]), b_ = xb_ld(&cen[8 + g_]); ok &= (a_ != 0u && a_ - 1u == 16u - b_) ? 1u : 0u; }
        seam_local = (int)__builtin_amdgcn_readfirstlane(ok) & SEAM_LOCAL_ENABLE; }
    if (IN(1)) { LAS float* sh = (LAS float*)lds;
        if (G == 256) {
            const int bg = vcu >> 5;
            for (int i = tid; i < D; i += NWAVES * 64) sh[i] = modacc[bg * NMOD + 3 * D + i] + bada[3 * D + i];
            __syncthreads();
            for (int n = (vcu & 31) * NWAVES + wave; n < FF; n += 32 * NWAVES) p1_sb_row1(sh, W1_t, sbv + bg * FF, n, lane);
        } else {
        for (int i = tid; i < 8 * D; i += NWAVES * 64) sh[i] = modacc[(i >> 10) * NMOD + 3 * D + (i & 1023)] + bada[3 * D + (i & 1023)];
        __syncthreads();
        for (int n = gw; n < FF; n += NGW) p1_sb_row(sh, W1_t, sbv, n, lane);
        }
        norm_mod_pass(x, g1, modacc, bada, 0, 1, XN, gw, NGW, lane);
        __syncthreads(); }
    SEAM(1);
    if (IN(2)) { pg8::Gemm g{XN, Win_t, M, DIN, D}; pg8::StaticOrder S; S.init(M, DIN, G, bx); pg8::EpiStore<0> E{PROJ, DIN};
        pg8::gemm_phase<pg8::EpiStore<0>, pg8::StaticOrder, true, true>(lds, g, S, E); }
    SEAM(2);
    if (IN(3)) { for (int j = vcu; j < 512; j += G) { const int jj = j & 255, bh = jj >> 2, s = jj & 3, qb = (j < 256) ? s : 7 - s;
            sba::attn_unit(bh >> 3, bh & 7, qb, PROJ, gq, gk, MIX, alt ? scrf : ssq_a, lds); }
        conv_norm_pass(PROJ, convw, gconv, MIX, gw, NGW, lane); }
    SEAM(3);
    if (IN(4)) { pg8::Gemm g{MIX, Wo_t, M, D, D}; pg8::StaticOrder S; S.init(M, D, G, bx); pg8::EpiWo E{x, X1B, XN, modacc, bada, g2, ssq_a, alt ? scrf : ssq2, lds};
        { pg8::Unit u0; if (S.next(0, u0)) E.pre(u0, 0, tid); __syncthreads(); }
        pg8::gemm_phase<pg8::EpiWo, pg8::StaticOrder, false, true>(lds, g, S, E); }
    SEAM(4);
    if (IN(5)) { pg8::Gemm g{XN, W1_t, M, FF, D}; pg8::StaticOrder S; S.init(M, FF, G, bx); pg8::EpiUp E{HB, ssq2, sbv};
        pg8::gemm_phase<pg8::EpiUp, pg8::StaticOrder, true, true>(lds, g, S, E); }
    SEAM(5);
    if (IN(6)) { pg8::Gemm g{HB, W2_t, M, D, FF}; pg8::StaticOrder S; S.init(M, D, G, bx); pg8::EpiResGate E{X1B, alt ? scrf : out, modacc, bada, 5 * D, lds};
        { pg8::Unit u0; if (S.next(0, u0)) E.pre(u0, 0, tid); __syncthreads(); }
        pg8::gemm_phase<pg8::EpiResGate, pg8::StaticOrder, false, true>(lds, g, S, E); }
#undef IN
#undef SEAM
#undef tid
#undef lane
}

#ifndef MK_SPLIT
#define MK_SPLIT 0
#endif
extern "C" void kernel_launch(void* const* d_in, const int* in_sizes, int n_in, void* d_out, int out_size, void* d_ws, size_t ws_size, hipStream_t stream) {
    static int grid = 0;
    if (grid == 0) {
        int dev = 0, cus = 0, per_cu = 0;
        if (n_in != 15 || out_size != M * D || ws_size < WS_END) { fprintf(stderr, "kernel_launch: unexpected shapes\n"); grid = -1; return; }
        hipGetDevice(&dev); hipDeviceGetAttribute(&cus, hipDeviceAttributeMultiprocessorCount, dev);
        if (hipFuncSetAttribute((const void*)mk_fwd, hipFuncAttributeMaxDynamicSharedMemorySize, LDS_BYTES) != hipSuccess) { fprintf(stderr, "kernel_launch: hipFuncSetAttribute failed\n"); grid = -1; return; }
        if (hipOccupancyMaxActiveBlocksPerMultiprocessor(&per_cu, (const void*)mk_fwd, NWAVES * 64, LDS_BYTES) != hipSuccess || per_cu < 1) { fprintf(stderr, "kernel_launch: the occupancy query reports %d resident workgroups per CU for this kernel; a grid-wide barrier needs at least 1; nothing launched\n", per_cu); grid = -1; return; }
        (void)hipGetLastError();
        if (cus != 256) { fprintf(stderr, "kernel_launch: built for a 256-CU device (one 256x256 unit per workgroup in the N=1024 GEMM phases); got %d CUs\n", cus); grid = -1; return; }
        grid = cus * (per_cu < 1 ? per_cu : 1);
    }
    if (grid < 0) return;
    (void)hipMemsetAsync((char*)d_ws + WS_CTL, 0, CTL_ZERO_BYTES, stream);
    Args a{};
    for (int i = 0; i < 15; ++i) a.in[i] = (const float*)d_in[i];
    a.out = (float*)d_out; a.ws = (unsigned char*)d_ws;
#if MK_SPLIT
    for (int p = 0; p < N_PHASES; ++p) { a.ph_lo = p; a.ph_hi = p + 1; a.coop = 0; a.pad = 0; hipLaunchKernelGGL(mk_fwd, dim3(grid), dim3(NWAVES * 64), LDS_BYTES, stream, a);
        if (p == PROBE_DUP) { a.pad = 1; hipLaunchKernelGGL(mk_fwd, dim3(grid), dim3(NWAVES * 64), LDS_BYTES, stream, a); } }
#else
    a.ph_lo = 0; a.ph_hi = N_PHASES; a.coop = 1;
    void* kargs[] = {&a};
    hipError_t e = hipLaunchCooperativeKernel((const void*)mk_fwd, dim3(grid), dim3(NWAVES * 64), kargs, LDS_BYTES, stream);
    if (e != hipSuccess) fprintf(stderr, "kernel_launch: cooperative launch failed: %s (grid %d)\n", hipGetErrorString(e), grid);
#endif
}
```

```cpp
#include <hip/hip_runtime.h>
#include <hip/hip_cooperative_groups.h>
#include <cstdio>
#include <cstdint>
namespace cg = cooperative_groups;
__device__ __forceinline__ int lane_now() { int l; asm volatile("v_mbcnt_lo_u32_b32 %0, -1, 0\n\tv_mbcnt_hi_u32_b32 %0, -1, %0" : "=v"(l)); return l; }
namespace pg8 {
#define PG8_LAS __attribute__((address_space(3)))
typedef unsigned short bf16_t;
typedef short bf16x8 __attribute__((ext_vector_type(8)));
typedef float f32x4 __attribute__((ext_vector_type(4)));
typedef unsigned u32x4 __attribute__((ext_vector_type(4)));
constexpr int BM = 256, BK = 64, HALF = 128, HTB = HALF * BK * 2  , STAGE_BYTES = 8 * HTB, NXCD = 8, WGM = 8;

__host__ __device__ __forceinline__ int lds_byte(int r, int c) { const int st = (r >> 4) * 2 + (c >> 5), rr = r & 15, cc = c & 31, ob = rr * 64 + cc * 2; return st * 1024 + (ob ^ (((ob >> 9) & 1) << 5)); }
__host__ __device__ __forceinline__ void stage_rc(int b, int& R, int& C) { const int st = b / 1024, sb = b % 1024, swz = sb ^ (((sb >> 9) & 1) << 5); R = (st >> 1) * 16 + swz / 64; C = (st & 1) * 32 + (swz % 64) / 2; }
__host__ __device__ __forceinline__ int perm32(int rho) { const int n = rho >> 4, i = rho & 15; return 8 * (i >> 2) + 4 * n + (i & 3); }

struct Unit { int pm, pn; };
struct Gemm { const bf16_t* A; const bf16_t* Bt; int M, N, K; };

struct StaticOrder {
    int nM, nN, nwg, G, c;
    __host__ __device__ void init(int M, int N, int G_, int c_) { nM = M / BM; nN = N / BM; nwg = nM * nN; G = G_; c = c_; }
    __host__ __device__ bool next(int i, Unit& u) const {
        const long L = (long)i * G + c; if (L >= nwg) return false;
        int wgid = (int)L; { const int q = nwg / NXCD, r = nwg % NXCD, xcd = wgid % NXCD, off = wgid / NXCD; wgid = (xcd < r ? xcd * (q + 1) : r * (q + 1) + (xcd - r) * q) + off; }
        const int nig = WGM * nN, gid = wgid / nig, fm = gid * WGM, gsz = (nM - fm) < WGM ? (nM - fm) : WGM;
        u.pm = fm + ((wgid % nig) % gsz); u.pn = (wgid % nig) / gsz; return true;
    }
    __device__ __forceinline__ void a_ready(const Unit&) const {}
    __device__ __forceinline__ void done(const Unit&) const {}
};

__device__ __forceinline__ unsigned cvt_pk_bf16(float lo, float hi) { unsigned r; asm volatile("v_cvt_pk_bf16_f32 %0, %1, %2" : "=v"(r) : "v"(lo), "v"(hi)); return r; }
typedef float f32x2 __attribute__((ext_vector_type(2)));
__device__ __forceinline__ f32x2 gelu_pk(f32x2 v) {
    const f32x2 av = __builtin_elementwise_abs(v), d = av * 0.2316418882f + 1.0f;
    f32x2 t; t.x = __builtin_amdgcn_rcpf(d.x); t.y = __builtin_amdgcn_rcpf(d.y);
    f32x2 q = t * 0.5307027145f + (-0.7265760135f); q = q * t + 0.7107068705f; q = q * t + (-0.142248368f); q = q * t + 0.127414796f; q = q * t;
    const f32x2 s = (v * v) * (-0.72134752044f);
    f32x2 e; e.x = __builtin_amdgcn_exp2f(s.x); e.y = __builtin_amdgcn_exp2f(s.y);
    const f32x2 m = v * (q * e), r = v - m;
    f32x2 o; o.x = v.x < 0.f ? m.x : r.x; o.y = v.y < 0.f ? m.y : r.y; return o;
}

template <int ACT  > struct EpiBf16 {
    static constexpr bool PERM = true, AFTER_DRAIN = false; static_assert(ACT == 0 || ACT == 1, "EpiBf16: ACT is 0 (none) or 1 (gelu_pk)");
    bf16_t* O; int ldc; const float* bias; int split_cols; size_t split_stride; float scale0;
    __device__ __forceinline__ void operator()(const f32x4 (&acc)[2][2][4][2], const Unit& u, int wr, int wc, int fr, int fq) const {
        const int row0 = u.pm * BM + wr * 64 + fr; int colt = u.pn * BM; bf16_t* base = O;
        float sc = 1.f; if (split_cols) { const int t = colt / split_cols; base += (size_t)t * split_stride; colt -= t * split_cols; if (t == 0) sc = scale0; }
        const int col0 = colt + wc * 32 + 8 * fq, bcol0 = u.pn * BM + wc * 32 + 8 * fq;
        f32x4 bv[2][2];
#pragma unroll
        for (int bj = 0; bj < 2; ++bj)
#pragma unroll
            for (int n = 0; n < 2; ++n) bv[bj][n] = bias ? *(const f32x4*)(bias + bcol0 + bj * HALF + 4 * n) : (f32x4){0.f, 0.f, 0.f, 0.f};
#pragma unroll
        for (int ai = 0; ai < 2; ++ai)
#pragma unroll
            for (int m = 0; m < 4; ++m) { bf16_t* rowp = base + (size_t)(row0 + ai * HALF + m * 16) * ldc + col0;
#pragma unroll
                for (int bj = 0; bj < 2; ++bj) { f32x4 v0 = acc[ai][bj][m][0] + bv[bj][0], v1 = acc[ai][bj][m][1] + bv[bj][1];
                    if (ACT == 1) { f32x2 a = gelu_pk((f32x2){v0[0], v0[1]}), b = gelu_pk((f32x2){v0[2], v0[3]}), c = gelu_pk((f32x2){v1[0], v1[1]}), d = gelu_pk((f32x2){v1[2], v1[3]});
                        v0 = (f32x4){a.x, a.y, b.x, b.y}; v1 = (f32x4){c.x, c.y, d.x, d.y}; }
                    v0 = v0 * sc; v1 = v1 * sc; u32x4 w; w.x = cvt_pk_bf16(v0[0], v0[1]); w.y = cvt_pk_bf16(v0[2], v0[3]); w.z = cvt_pk_bf16(v1[0], v1[1]); w.w = cvt_pk_bf16(v1[2], v1[3]);
                    *(u32x4*)(rowp + bj * HALF) = w; } }
    }
};
template <int ACT> struct EpiStore {
    static constexpr bool PERM = true, AFTER_DRAIN = false, MIDK = false, SCALE = false;
    bf16_t* O; int ldc;
    __device__ __forceinline__ void operator()(const f32x4 (&acc)[2][2][4][2], const Unit& u, int ui, int wr, int wc, int fr, int fq) const {
        const int row0 = u.pm * BM + wr * 64 + fr; const int col0 = u.pn * BM + wc * 32 + 8 * fq;
#pragma unroll
        for (int ai = 0; ai < 2; ++ai)
#pragma unroll
            for (int m = 0; m < 4; ++m) { bf16_t* rowp = O + (size_t)(row0 + ai * HALF + m * 16) * ldc + col0;
#pragma unroll
                for (int bj = 0; bj < 2; ++bj) { f32x4 v0 = acc[ai][bj][m][0], v1 = acc[ai][bj][m][1];
                    if (ACT == 2) {
#pragma unroll
                        for (int e = 0; e < 4; ++e) { float a = fmaxf(v0[e], 0.f), b = fmaxf(v1[e], 0.f); v0[e] = a * a; v1[e] = b * b; } }
                    u32x4 w; w.x = cvt_pk_bf16(v0[0], v0[1]); w.y = cvt_pk_bf16(v0[2], v0[3]); w.z = cvt_pk_bf16(v1[0], v1[1]); w.w = cvt_pk_bf16(v1[2], v1[3]);
                    *(u32x4*)(rowp + bj * HALF) = w; } }
    }
};
#define PG8_TAB(lds, par) ((PG8_LAS float*)((lds) + 132096 + (par) * 3072))
struct EpiResGate {
    static constexpr bool PERM = false, AFTER_DRAIN = false, MIDK = false, SCALE = false;
    const bf16_t* base; float* out; const float* modacc; const float* bada; int goff; PG8_LAS unsigned char* lds;
    __device__ __forceinline__ void pre(const Unit& u, int ui, int tid_) const { int tid = tid_; asm volatile("" : "+v"(tid));
        if (tid < 256) { const int c = goff + u.pn * BM + tid; PG8_TAB(lds, 0)[256 + tid] = modacc[(u.pm >> 3) * 6144 + c] + bada[c]; }
    }
    __device__ __forceinline__ void operator()(const f32x4 (&acc)[2][2][4][2], const Unit& u, int ui, int wr, int wc, int fr, int fq) const {
        typedef unsigned u32x2v __attribute__((ext_vector_type(2)));
        const PG8_LAS float* tab = PG8_TAB(lds, 0) + 256;
        const int cl0 = wc * 32 + 4 * fq; const size_t off0 = (size_t)(u.pm * BM + wr * 64 + fr) * 1024 + u.pn * BM + cl0;
        u32x2v xb[2][8];
#define PG8_LDX(g, buf) do { _Pragma("unroll") for (int q_ = 0; q_ < 8; ++q_) xb[buf][q_] = *(const u32x2v*)(base + off0 + (size_t)((q_ >> 2) * HALF + (q_ & 3) * 16) * 1024 + ((g) >> 1) * HALF + ((g) & 1) * 16); } while (0)
        PG8_LDX(0, 0);
#pragma unroll
        for (int g = 0; g < 4; ++g) { const int bj = g >> 1, n = g & 1;
            if (g < 3) PG8_LDX(g + 1, (g + 1) & 1);
            const f32x4 gv = *(const PG8_LAS f32x4*)(tab + cl0 + bj * HALF + n * 16);
#pragma unroll
            for (int q = 0; q < 8; ++q) { const int ai = q >> 2, m = q & 3; const u32x2v w = xb[g & 1][q];
                const f32x4 bs = {__builtin_bit_cast(float, w.x << 16), __builtin_bit_cast(float, w.x & 0xffff0000u), __builtin_bit_cast(float, w.y << 16), __builtin_bit_cast(float, w.y & 0xffff0000u)};
                __builtin_nontemporal_store(bs + gv * acc[ai][bj][m][n], (f32x4*)(out + off0 + (size_t)(ai * HALF + m * 16) * 1024 + bj * HALF + n * 16)); } }
#undef PG8_LDX
    }
};
struct EpiWo {
    static constexpr bool PERM = false, AFTER_DRAIN = false, MIDK = false, SCALE = true;
    const float* base; bf16_t* x1b; bf16_t* xn; const float* modacc; const float* bada; const float* g2; const float* ssq_a; float* ssq2; PG8_LAS unsigned char* lds;
    __device__ __forceinline__ void pre(const Unit& u, int ui, int tid_) const { int tid = tid_; asm volatile("" : "+v"(tid));
        PG8_LAS float* tab = PG8_TAB(lds, 0);
        if (tid < 256) { const int c = u.pn * BM + tid, b = u.pm >> 3;
            tab[256 + tid] = modacc[b * 6144 + 2048 + c] + bada[2048 + c];
            tab[512 + tid] = g2[c] * (modacc[b * 6144 + 4096 + c] + bada[4096 + c] + 1.0f); }
        else tab[tid - 256] = 1.0f / sqrtf(ssq_a[u.pm * BM + tid - 256] * (1.f / 512.f) + 1e-6f);
    }
    __device__ __forceinline__ void mid(f32x4 (&acc)[2][2][4][2], const Unit& u, int ui, int wr, int wc, int fr, int fq) const {
        const PG8_LAS float* tab = PG8_TAB(lds, 0); int frp = fr; asm volatile("" : "+v"(frp));
#pragma unroll
        for (int ai = 0; ai < 2; ++ai)
#pragma unroll
            for (int m = 0; m < 4; ++m) { const float ra = tab[ai * HALF + wr * 64 + m * 16 + frp];
#pragma unroll
                for (int bj = 0; bj < 2; ++bj)
#pragma unroll
                    for (int n = 0; n < 2; ++n) acc[ai][bj][m][n] *= ra; }
    }
    __device__ __forceinline__ void operator()(const f32x4 (&acc)[2][2][4][2], const Unit& u, int ui, int wr, int wc, int fr, int fq) const {
        typedef unsigned u32x2v __attribute__((ext_vector_type(2)));
        const PG8_LAS float* tab = PG8_TAB(lds, 0);
        const int cl0 = wc * 32 + 4 * fq; const int rowb = u.pm * BM + wr * 64 + fr; const size_t off0 = (size_t)rowb * 1024 + u.pn * BM + cl0;
        float ss[8];
#pragma unroll
        for (int q = 0; q < 8; ++q) ss[q] = 0.f;
        f32x4 xb[2][4];
#define PG8_LDX(g, buf) do { _Pragma("unroll") for (int q_ = 0; q_ < 4; ++q_) xb[buf][q_] = __builtin_nontemporal_load((const f32x4*)(base + off0 + (size_t)(((g) & 1) * HALF + q_ * 16) * 1024 + ((g) >> 2) * HALF + (((g) >> 1) & 1) * 16)); } while (0)
        PG8_LDX(0, 0);
#pragma unroll
        for (int g = 0; g < 8; ++g) { const int bj = g >> 2, n = (g >> 1) & 1, ai = g & 1;
            if (g < 7) PG8_LDX(g + 1, (g + 1) & 1);
            const f32x4 gv = *(const PG8_LAS f32x4*)(tab + 256 + cl0 + bj * HALF + n * 16), av = *(const PG8_LAS f32x4*)(tab + 512 + cl0 + bj * HALF + n * 16);
#pragma unroll
            for (int m = 0; m < 4; ++m) { const size_t off = off0 + (size_t)(ai * HALF + m * 16) * 1024 + bj * HALF + n * 16;
                const f32x4 x1 = xb[g & 1][m] + gv * acc[ai][bj][m][n];
                u32x2v w; w.x = cvt_pk_bf16(x1[0], x1[1]); w.y = cvt_pk_bf16(x1[2], x1[3]);
                *(u32x2v*)(x1b + off) = w;
                ss[ai * 4 + m] += (x1[0] * x1[0] + x1[1] * x1[1]) + (x1[2] * x1[2] + x1[3] * x1[3]);
                const f32x4 y = x1 * av; w.x = cvt_pk_bf16(y[0], y[1]); w.y = cvt_pk_bf16(y[2], y[3]);
                *(u32x2v*)(xn + off) = w; } }
#undef PG8_LDX
#pragma unroll
        for (int q = 0; q < 8; ++q) { float s = ss[q]; s += __shfl_xor(s, 16); s += __shfl_xor(s, 32);
            if (fq == 0) atomicAdd(ssq2 + rowb + (q >> 2) * HALF + (q & 3) * 16, s); }
    }
};
struct EpiUp {
    static constexpr bool PERM = true, AFTER_DRAIN = false, MIDK = false, SCALE = false;
    bf16_t* O; const float* ssq2; const float* sb;
    __device__ __forceinline__ void operator()(const f32x4 (&acc)[2][2][4][2], const Unit& u, int ui, int wr, int wc, int fr, int fq) const {
        const int b = u.pm >> 3; const int row0 = u.pm * BM + wr * 64 + fr; const int col0 = u.pn * BM + wc * 32 + 8 * fq;
        f32x4 sv[2][2]; float rv[2][4];
#pragma unroll
        for (int ai = 0; ai < 2; ++ai)
#pragma unroll
            for (int m = 0; m < 4; ++m) rv[ai][m] = ssq2[row0 + ai * HALF + m * 16];
#pragma unroll
        for (int bj = 0; bj < 2; ++bj)
#pragma unroll
            for (int n = 0; n < 2; ++n) sv[bj][n] = *(const f32x4*)(sb + b * 4096 + col0 + bj * HALF + 4 * n);
#pragma unroll
        for (int ai = 0; ai < 2; ++ai)
#pragma unroll
            for (int m = 0; m < 4; ++m) { const int row = row0 + ai * HALF + m * 16; const float rinv = 1.0f / sqrtf(rv[ai][m] * (1.f / 1024.f) + 1e-6f);
                bf16_t* rowp = O + (size_t)row * 4096 + col0;
#pragma unroll
                for (int bj = 0; bj < 2; ++bj) { f32x4 v0 = acc[ai][bj][m][0] * rinv + sv[bj][0], v1 = acc[ai][bj][m][1] * rinv + sv[bj][1];
#pragma unroll
                    for (int e = 0; e < 4; ++e) { const float a = fmaxf(v0[e], 0.f), c = fmaxf(v1[e], 0.f); v0[e] = a * a; v1[e] = c * c; }
                    u32x4 w; w.x = cvt_pk_bf16(v0[0], v0[1]); w.y = cvt_pk_bf16(v0[2], v0[3]); w.z = cvt_pk_bf16(v1[0], v1[1]); w.w = cvt_pk_bf16(v1[2], v1[3]);
                    *(u32x4*)(rowp + bj * HALF) = w; } }
    }
};
template <class Epi, class Sched, bool ALIGN_EPI = false, bool SP2 = false>
__device__ __forceinline__ void gemm_phase(PG8_LAS unsigned char* lds, const Gemm g, const Sched& S, const Epi& E) {
    const int wid = __builtin_amdgcn_readfirstlane(threadIdx.x >> 6), lane = lane_now(), tid = wid * 64 + lane, wr = wid >> 2, wc = wid & 3, fr = lane & 15, fq = lane >> 4;
    const int K = g.K, nt = K / BK;
    unsigned voffA[2], voffB[2];
#pragma unroll
    for (int i = 0; i < 2; ++i) { int R, C; stage_rc(tid * 16 + i * 8192, R, C); const int Rb = Epi::PERM ? ((R & ~31) + perm32(R & 31)) : R;
        voffA[i] = (unsigned)(R * K + C) * 2u; voffB[i] = (unsigned)(Rb * K + C) * 2u; }
    const size_t kstep = (size_t)(BK * 2);
    const size_t hstep = (size_t)HALF * K * 2;
    const size_t tstep = 2 * hstep;
    const unsigned ldsw = (unsigned)wid * 1024u;
    const int aoff = lds_byte(wr * 64 + fr, fq * 8), boff = lds_byte(wc * 32 + fr, fq * 8);
#define PG8_SA(b, h) (((b) * 2 + (h)) * HTB)
#define PG8_SB(b, h) ((4 + (b) * 2 + (h)) * HTB)
#define PG8_STAGE(bufoff, gbase, voff) do { _Pragma("unroll") for (int _i = 0; _i < 2; ++_i) \
        __builtin_amdgcn_global_load_lds((const unsigned*)((const char*)(gbase) + (voff)[_i]), (PG8_LAS unsigned*)(lds + (bufoff) + ldsw + _i * 8192), 16, 0, 0); } while (0)
#define PG8_LDA(dst, b, h) do { _Pragma("unroll") for (int m = 0; m < 4; ++m) _Pragma("unroll") for (int k = 0; k < 2; ++k) dst[m][k] = *(const PG8_LAS bf16x8*)(lds + PG8_SA(b, h) + aoff + m * 2048 + k * 1024); } while (0)
#define PG8_LDB(dst, b, h) do { _Pragma("unroll") for (int n = 0; n < 2; ++n) _Pragma("unroll") for (int k = 0; k < 2; ++k) dst[n][k] = *(const PG8_LAS bf16x8*)(lds + PG8_SB(b, h) + boff + n * 2048 + k * 1024); } while (0)
#define PG8_MMA(ai, bj, At, Bt) do { __builtin_amdgcn_s_setprio(1); _Pragma("unroll") for (int m = 0; m < 4; ++m) _Pragma("unroll") for (int n = 0; n < 2; ++n) _Pragma("unroll") for (int k = 0; k < 2; ++k) \
        acc[ai][bj][m][n] = __builtin_amdgcn_mfma_f32_16x16x32_bf16(Bt[n][k], At[m][k], acc[ai][bj][m][n], 0, 0, 0); __builtin_amdgcn_s_setprio(0); } while (0)
#define PG8_WAIT_V(n) asm volatile("s_waitcnt vmcnt(" #n ")" ::: "memory")
#define PG8_WAIT_L(n) asm volatile("s_waitcnt lgkmcnt(" #n ")" ::: "memory")
#define PG8_BAR __builtin_amdgcn_s_barrier()
#define PG8_SCHED __builtin_amdgcn_sched_barrier(0)
    Unit cur, nxt; int ui = 0;
    if (!S.next(0, cur)) return;
    f32x4 acc[2][2][4][2];
#pragma unroll
    for (int a = 0; a < 2; ++a)
#pragma unroll
        for (int b = 0; b < 2; ++b)
#pragma unroll
            for (int m = 0; m < 4; ++m)
#pragma unroll
                for (int n = 0; n < 2; ++n) acc[a][b][m][n] = (f32x4){0.f, 0.f, 0.f, 0.f};
    bf16x8 At[4][2], B0[2][2], B1[2][2];
    const char* cA = (const char*)g.A + (size_t)cur.pm * tstep; const char* cB = (const char*)g.Bt + (size_t)cur.pn * tstep;
    S.a_ready(cur);
    if constexpr (SP2) {
        PG8_STAGE(PG8_SB(0, 0), cB, voffB); PG8_STAGE(PG8_SB(0, 1), cB + hstep, voffB); PG8_STAGE(PG8_SA(0, 0), cA, voffA); PG8_STAGE(PG8_SA(0, 1), cA + hstep, voffA);
        if (wr == 1) PG8_BAR;
        PG8_WAIT_V(2); PG8_BAR;
        PG8_STAGE(PG8_SB(1, 0), cB + kstep, voffB); PG8_STAGE(PG8_SA(1, 0), cA + kstep, voffA); PG8_STAGE(PG8_SB(1, 1), cB + hstep + kstep, voffB);
        PG8_WAIT_V(6); PG8_BAR;
    } else {
        PG8_STAGE(PG8_SB(0, 0), cB, voffB); PG8_STAGE(PG8_SA(0, 0), cA, voffA); PG8_STAGE(PG8_SB(0, 1), cB + hstep, voffB); PG8_STAGE(PG8_SA(0, 1), cA + hstep, voffA);
        if (wr == 1) PG8_BAR;
        PG8_WAIT_V(4); PG8_BAR;
        PG8_STAGE(PG8_SB(1, 0), cB + kstep, voffB); PG8_STAGE(PG8_SA(1, 0), cA + kstep, voffA); PG8_STAGE(PG8_SB(1, 1), cB + hstep + kstep, voffB);
        PG8_WAIT_V(6); PG8_BAR;
    }
    for (;;) {
        const bool has_next = S.next(ui + 1, nxt);
        const char* nA = has_next ? (const char*)g.A + (size_t)nxt.pm * tstep : cA; const char* nB = has_next ? (const char*)g.Bt + (size_t)nxt.pn * tstep : cB;
        for (int t = 0; t < nt; t += 2) {
            const bool last = (t == nt - 2);
            const char* a1 = cA + (size_t)(t + 1) * kstep;
            const char* a2 = last ? nA : cA + (size_t)(t + 2) * kstep; const char* b2 = last ? nB : cB + (size_t)(t + 2) * kstep;
            const char* a3 = a2 + kstep; const char* b3 = b2 + kstep;
            if (last && has_next) S.a_ready(nxt);
            if constexpr (Epi::SCALE) { if (t == nt / 2) E.mid(acc, cur, ui, wr, wc, fr, fq); }
            if constexpr (SP2) {
            PG8_LDB(B0, 0, 0); PG8_LDB(B1, 0, 1); PG8_SCHED; PG8_LDA(At, 0, 0); PG8_STAGE(PG8_SA(1, 1), a1 + hstep, voffA);
            PG8_WAIT_V(8); PG8_WAIT_L(0); PG8_BAR; PG8_MMA(0, 0, At, B0); PG8_MMA(0, 1, At, B1); PG8_BAR; PG8_SCHED;
            PG8_LDA(At, 0, 1); PG8_STAGE(PG8_SB(0, 0), b2, voffB); PG8_STAGE(PG8_SB(0, 1), b2 + hstep, voffB); PG8_STAGE(PG8_SA(0, 0), a2, voffA);
            PG8_WAIT_V(8); PG8_WAIT_L(0); PG8_BAR; PG8_MMA(1, 0, At, B0); PG8_MMA(1, 1, At, B1); PG8_BAR; PG8_SCHED;
            PG8_LDB(B0, 1, 0); PG8_LDB(B1, 1, 1); PG8_SCHED; PG8_LDA(At, 1, 0); PG8_STAGE(PG8_SA(0, 1), a2 + hstep, voffA);
            PG8_WAIT_V(8); PG8_WAIT_L(0); PG8_BAR; PG8_MMA(0, 0, At, B0); PG8_MMA(0, 1, At, B1); PG8_BAR; PG8_SCHED;
            PG8_LDA(At, 1, 1); PG8_STAGE(PG8_SB(1, 0), b3, voffB); PG8_STAGE(PG8_SB(1, 1), b3 + hstep, voffB); PG8_STAGE(PG8_SA(1, 0), a3, voffA);
            PG8_WAIT_V(8); PG8_WAIT_L(0); PG8_BAR; PG8_MMA(1, 0, At, B0); PG8_MMA(1, 1, At, B1); PG8_BAR; PG8_SCHED;
            } else {
            PG8_LDB(B0, 0, 0); PG8_SCHED; PG8_LDA(At, 0, 0); PG8_STAGE(PG8_SA(1, 1), a1 + hstep, voffA);
            PG8_WAIT_L(8); PG8_BAR; PG8_WAIT_L(0); PG8_MMA(0, 0, At, B0); PG8_BAR; PG8_SCHED;
            PG8_LDB(B1, 0, 1); PG8_STAGE(PG8_SB(0, 0), b2, voffB);
            PG8_BAR; PG8_WAIT_L(0); PG8_MMA(0, 1, At, B1); PG8_BAR;
            PG8_LDA(At, 0, 1); PG8_STAGE(PG8_SA(0, 0), a2, voffA);
            PG8_BAR; PG8_WAIT_L(0); PG8_MMA(1, 0, At, B0); PG8_BAR; PG8_SCHED;
            PG8_STAGE(PG8_SB(0, 1), b2 + hstep, voffB);
            PG8_WAIT_V(6); PG8_BAR; PG8_MMA(1, 1, At, B1); PG8_BAR;
            PG8_LDB(B0, 1, 0); PG8_SCHED; PG8_LDA(At, 1, 0); PG8_STAGE(PG8_SA(0, 1), a2 + hstep, voffA);
            PG8_WAIT_L(8); PG8_BAR; PG8_WAIT_L(0); PG8_MMA(0, 0, At, B0); PG8_BAR; PG8_SCHED;
            PG8_LDB(B1, 1, 1); PG8_STAGE(PG8_SB(1, 0), b3, voffB);
            PG8_BAR; PG8_WAIT_L(0); PG8_MMA(0, 1, At, B1); PG8_BAR;
            PG8_LDA(At, 1, 1); PG8_STAGE(PG8_SA(1, 0), a3, voffA);
            PG8_BAR; PG8_WAIT_L(0); PG8_MMA(1, 0, At, B0); PG8_BAR; PG8_SCHED;
            PG8_STAGE(PG8_SB(1, 1), b3 + hstep, voffB);
            PG8_WAIT_V(6); PG8_BAR; PG8_MMA(1, 1, At, B1); PG8_BAR;
            }
        }
        if constexpr (ALIGN_EPI) { if (wr == 0) PG8_BAR; }
        if constexpr (!Epi::AFTER_DRAIN) { E(acc, cur, ui, wr, wc, fr, fq); S.done(cur); }
        if (!has_next) break;
#pragma unroll
        for (int a = 0; a < 2; ++a)
#pragma unroll
            for (int b = 0; b < 2; ++b)
#pragma unroll
                for (int m = 0; m < 4; ++m)
#pragma unroll
                    for (int n = 0; n < 2; ++n) acc[a][b][m][n] = (f32x4){0.f, 0.f, 0.f, 0.f};
        cur = nxt; cA = nA; cB = nB; ++ui;
        if constexpr (ALIGN_EPI) { if (wr == 1) PG8_BAR; }
    }
    PG8_WAIT_V(0);
    if constexpr (!ALIGN_EPI) { if (wr == 0) PG8_BAR; }
    PG8_BAR;
    if constexpr (Epi::AFTER_DRAIN) { E.fused(acc, cur, wr, wc, fr, fq, lds, wid, lane); S.done(cur); }
#undef PG8_SA
#undef PG8_SB
#undef PG8_STAGE
#undef PG8_LDA
#undef PG8_LDB
#undef PG8_MMA
#undef PG8_WAIT_V
#undef PG8_WAIT_L
#undef PG8_BAR
#undef PG8_SCHED
}
}
constexpr int NB = 8, SEQ = 2048, D = 1024, FF = 4096, M = NB * SEQ;
constexpr int DIN = 3072, CONVD = 512, NH = 8, HD = 64;
constexpr int COL_B = 0, COL_C = 512, COL_U = 1024, COL_Q = 1536, COL_K = 2048, COL_V = 2560;
constexpr int NMOD = 6144;
constexpr float EPS = 1e-6f;
constexpr int NWAVES = 8;
constexpr size_t MiB = 1u << 20;
constexpr size_t WS_CTL = 0, CTL_ZERO_BYTES = 1 * MiB;
constexpr size_t WS_SSQA = 320 * 1024, WS_SSQ2 = 384 * 1024, WS_SB = 512 * 1024;
constexpr size_t WS_CEN = 208 * 1024;
constexpr size_t WS_BAR = 256 * 1024;
constexpr size_t WS_WIN = 2 * MiB, WS_WO = 8 * MiB, WS_W1 = 10 * MiB, WS_W2 = 18 * MiB;
constexpr size_t WS_PROJ = 32 * MiB;
constexpr size_t WS_MIX = 128 * MiB;
constexpr size_t WS_H = 32 * MiB;
constexpr size_t WS_XN = 160 * MiB;
constexpr size_t WS_X1B = 192 * MiB;
constexpr size_t WS_END = 256 * MiB;
constexpr int LDS_BYTES = 147456, MISC_OFF = 131072 + 320;

#define LAS __attribute__((address_space(3)))
typedef unsigned short bf16;
typedef unsigned v4u __attribute__((ext_vector_type(4)));
typedef unsigned v2u __attribute__((ext_vector_type(2)));
typedef float f32x4 __attribute__((ext_vector_type(4)));
typedef float f32x16 __attribute__((ext_vector_type(16)));
typedef short bf16x8 __attribute__((ext_vector_type(8)));
typedef short s16x4 __attribute__((ext_vector_type(4)));
#define LDS_WAIT() asm volatile("s_waitcnt lgkmcnt(0)" ::: "memory")

__device__ __forceinline__ unsigned f2bf(float f) { unsigned u = __builtin_bit_cast(unsigned, f); return (u + 0x7fffu + ((u >> 16) & 1u)) >> 16; }
__device__ __forceinline__ unsigned pk2(float lo, float hi) { return f2bf(lo) | (f2bf(hi) << 16); }
typedef float f32x2_t __attribute__((ext_vector_type(2))); typedef __bf16 bf16x2_t __attribute__((ext_vector_type(2)));
__device__ __forceinline__ unsigned cvtpk(float lo, float hi) { f32x2_t v = {lo, hi}; bf16x2_t b = __builtin_convertvector(v, bf16x2_t); return __builtin_bit_cast(unsigned, b); }
__device__ __forceinline__ float bflo(unsigned w) { return __builtin_bit_cast(float, w << 16); }
__device__ __forceinline__ float bfhi(unsigned w) { return __builtin_bit_cast(float, w & 0xffff0000u); }
__device__ __forceinline__ void unpack8(const v4u r, float (&f)[8]) { f[0] = bflo(r.x); f[1] = bfhi(r.x); f[2] = bflo(r.y); f[3] = bfhi(r.y); f[4] = bflo(r.z); f[5] = bfhi(r.z); f[6] = bflo(r.w); f[7] = bfhi(r.w); }
__device__ __forceinline__ v4u pack8(const float (&f)[8]) { v4u o; o.x = cvtpk(f[0], f[1]); o.y = cvtpk(f[2], f[3]); o.z = cvtpk(f[4], f[5]); o.w = cvtpk(f[6], f[7]); return o; }
template <int CTRL> __device__ __forceinline__ float dpp_f(float v) { return __builtin_bit_cast(float, __builtin_amdgcn_mov_dpp(__builtin_bit_cast(int, v), CTRL, 0xF, 0xF, true)); }
__device__ __forceinline__ float sum8(float v) {
    v += dpp_f<0xB1>(v);
    v += dpp_f<0x4E>(v);
    v += dpp_f<0x141>(v);
    return v; }
__device__ __forceinline__ float wave_sum(float v) {
    v = sum8(v); v += dpp_f<0x140>(v);
    const int i = __builtin_bit_cast(int, v);
    return (__builtin_bit_cast(float, __builtin_amdgcn_readlane(i, 0)) + __builtin_bit_cast(float, __builtin_amdgcn_readlane(i, 16)))
         + (__builtin_bit_cast(float, __builtin_amdgcn_readlane(i, 32)) + __builtin_bit_cast(float, __builtin_amdgcn_readlane(i, 48)));
}

__device__ __forceinline__ void p0_transpose_item(const float* W, int K, int N, bf16* WT, LAS float* scr, int item, int lane) {
    const int nblk = N / 32, kb = item / nblk, nb = item % nblk, k0 = 64 * kb, n0 = 32 * nb;
    float wv[32];
#pragma unroll
    for (int i = 0; i < 32; ++i) { const int kk = 2 * i + (lane >> 5); wv[i] = __builtin_nontemporal_load(W + (size_t)(k0 + kk) * N + n0 + (lane & 31)); }
#pragma unroll
    for (int i = 0; i < 32; ++i) { const int kk = 2 * i + (lane >> 5); scr[kk * 33 + (lane & 31)] = wv[i]; }
    LDS_WAIT(); asm volatile("" ::: "memory");
    const int c = lane & 7;
#pragma unroll
    for (int j = 0; j < 4; ++j) { const int n = (lane >> 3) + 8 * j; const LAS float* s = scr + (8 * c) * 33 + n;
        v4u o; o.x = pk2(s[0 * 33], s[1 * 33]); o.y = pk2(s[2 * 33], s[3 * 33]); o.z = pk2(s[4 * 33], s[5 * 33]); o.w = pk2(s[6 * 33], s[7 * 33]);
        *(v4u*)(WT + (size_t)(n0 + n) * K + k0 + 8 * c) = o; }
    LDS_WAIT(); asm volatile("" ::: "memory");
}
__device__ __forceinline__ void p0_transpose_wo_item(const float* W, const float* gattn, bf16* WT, LAS float* scr, int item, int lane) {
    constexpr int K = 1024, N = 1024;
    const int nblk = N / 32, kb = item / nblk, nb = item % nblk, k0 = 64 * kb, n0 = 32 * nb;
    float wv[32];
#pragma unroll
    for (int i = 0; i < 32; ++i) { const int kk = 2 * i + (lane >> 5); wv[i] = __builtin_nontemporal_load(W + (size_t)(k0 + kk) * N + n0 + (lane & 31)); }
#pragma unroll
    for (int i = 0; i < 32; ++i) { const int kk = 2 * i + (lane >> 5); float w = wv[i]; if (k0 >= 512) w *= gattn[k0 - 512 + kk]; scr[kk * 33 + (lane & 31)] = w; }
    LDS_WAIT(); asm volatile("" ::: "memory");
    const int c = lane & 7, kd = (k0 + 512) & 1023;
#pragma unroll
    for (int j = 0; j < 4; ++j) { const int n = (lane >> 3) + 8 * j; const LAS float* s = scr + (8 * c) * 33 + n;
        v4u o; o.x = pk2(s[0 * 33], s[1 * 33]); o.y = pk2(s[2 * 33], s[3 * 33]); o.z = pk2(s[4 * 33], s[5 * 33]); o.w = pk2(s[6 * 33], s[7 * 33]);
        *(v4u*)(WT + (size_t)(n0 + n) * K + kd + 8 * c) = o; }
    LDS_WAIT(); asm volatile("" ::: "memory");
}
__device__ __forceinline__ void p0_gemv_item(const float* cvec, const float* wada, float* modacc, int item, int lane) {
    const int jb = item % 96, kc = item / 96, j = 64 * jb + lane, k0 = 64 * kc;
    float s[8], acc[8];
#pragma unroll
    for (int b = 0; b < 8; ++b) { const float v = cvec[b * D + k0 + lane]; s[b] = v / (1.f + __expf(-v)); acc[b] = 0.f; }
    const float* wp = wada + (size_t)k0 * NMOD + j;
#pragma unroll 32
    for (int kk = 0; kk < 64; ++kk) { const float w = __builtin_nontemporal_load(wp + (size_t)kk * NMOD);
#pragma unroll
        for (int b = 0; b < 8; ++b) acc[b] += __builtin_bit_cast(float, __builtin_amdgcn_readlane(__builtin_bit_cast(int, s[b]), kk)) * w; }
#pragma unroll
    for (int b = 0; b < 8; ++b) atomicAdd(modacc + b * NMOD + j, acc[b]);
}

__device__ __forceinline__ void p1_sb_row(const LAS float* sh, const bf16* W1t, float* sb, int n, int lane) {
    float acc[8];
#pragma unroll
    for (int b = 0; b < 8; ++b) acc[b] = 0.f;
#pragma unroll
    for (int j = 0; j < 4; ++j) { const v2u w = *(const v2u*)(W1t + (size_t)n * D + 256 * j + 4 * lane);
        const float w0 = bflo(w.x), w1 = bfhi(w.x), w2 = bflo(w.y), w3 = bfhi(w.y);
#pragma unroll
        for (int b = 0; b < 8; ++b) { const f32x4 s = *(const LAS f32x4*)(sh + b * D + 256 * j + 4 * lane); acc[b] += (s.x * w0 + s.y * w1) + (s.z * w2 + s.w * w3); } }
#pragma unroll
    for (int b = 0; b < 8; ++b) { const float t = wave_sum(acc[b]); if (lane == 0) sb[b * FF + n] = t; }
}
__device__ __forceinline__ void p1_sb_row1(const LAS float* sh, const bf16* W1t, float* sbrow, int n, int lane) {
    float acc = 0.f;
#pragma unroll
    for (int j = 0; j < 4; ++j) { const v2u w = *(const v2u*)(W1t + (size_t)n * D + 256 * j + 4 * lane); const f32x4 s = *(const LAS f32x4*)(sh + 256 * j + 4 * lane);
        acc += (s.x * bflo(w.x) + s.y * bfhi(w.x)) + (s.z * bflo(w.y) + s.w * bfhi(w.y)); }
    const float t = wave_sum(acc); if (lane == 0) sbrow[n] = t;
}
__device__ __forceinline__ void norm_mod_pass(const float* __restrict__ X, const float* __restrict__ g, const float* __restrict__ modacc, const float* __restrict__ bada, int shift_idx, int scale_idx, bf16* __restrict__ XN, int gw, int NGW, int lane) {
    for (int item = gw; item < M / 8; item += NGW) {
        const int row0 = item * 8, b = row0 / SEQ;
        f32x4 a[4], s[4];
#pragma unroll
        for (int j = 0; j < 4; ++j) { const int col = 4 * lane + 256 * j;
            const f32x4 gg = *(const f32x4*)(g + col);
            const f32x4 sc = *(const f32x4*)(modacc + b * NMOD + scale_idx * D + col) + *(const f32x4*)(bada + scale_idx * D + col);
            s[j] = *(const f32x4*)(modacc + b * NMOD + shift_idx * D + col) + *(const f32x4*)(bada + shift_idx * D + col);
            a[j] = gg * (sc + 1.0f); }
#pragma unroll 4
        for (int r = 0; r < 8; ++r) { const float* xr = X + (size_t)(row0 + r) * D + 4 * lane;
            f32x4 v[4]; float ss = 0.f;
#pragma unroll
            for (int j = 0; j < 4; ++j) { v[j] = __builtin_nontemporal_load((const f32x4*)(xr + 256 * j)); ss += (v[j].x * v[j].x + v[j].y * v[j].y) + (v[j].z * v[j].z + v[j].w * v[j].w); }
            const float rinv = 1.0f / sqrtf(wave_sum(ss) * (1.f / D) + EPS);
            bf16* orow = XN + (size_t)(row0 + r) * D + 4 * lane;
#pragma unroll
            for (int j = 0; j < 4; ++j) { const f32x4 y = v[j] * rinv * a[j] + s[j]; v2u o; o.x = cvtpk(y.x, y.y); o.y = cvtpk(y.z, y.w); *(v2u*)(orow + 256 * j) = o; } }
    }
}

__device__ __forceinline__ void conv_norm_pass(const bf16* __restrict__ PROJ, const float* __restrict__ convw, const float* __restrict__ gconv, bf16* __restrict__ MIX, int gw, int NGW, int lane) {
    const int c = 8 * lane;
    for (int item = gw; item < M / 8; item += NGW) {
        const int row0 = item * 8, t0 = row0 % SEQ;
        float w0[8], w1[8], w2[8], gc[8];
#pragma unroll
        for (int e = 0; e < 8; ++e) { w0[e] = convw[c + e]; w1[e] = convw[CONVD + c + e]; w2[e] = convw[2 * CONVD + c + e]; gc[e] = gconv[c + e]; }
        float cm2[8], cm1[8];
#pragma unroll
        for (int e = 0; e < 8; ++e) { cm2[e] = 0.f; cm1[e] = 0.f; }
        if (t0 != 0) { float a[8], u[8];
            unpack8(*(const v4u*)(PROJ + (size_t)(row0 - 2) * DIN + COL_C + c), a); unpack8(*(const v4u*)(PROJ + (size_t)(row0 - 2) * DIN + COL_U + c), u);
#pragma unroll
            for (int e = 0; e < 8; ++e) cm2[e] = a[e] * u[e];
            unpack8(*(const v4u*)(PROJ + (size_t)(row0 - 1) * DIN + COL_C + c), a); unpack8(*(const v4u*)(PROJ + (size_t)(row0 - 1) * DIN + COL_U + c), u);
#pragma unroll
            for (int e = 0; e < 8; ++e) cm1[e] = a[e] * u[e]; }
#pragma unroll
        for (int r = 0; r < 8; ++r) { const size_t row = (size_t)(row0 + r);
            float bg[8], cgv[8], u[8], y[8];
            unpack8(__builtin_nontemporal_load((const v4u*)(PROJ + row * DIN + COL_B + c)), bg); unpack8(__builtin_nontemporal_load((const v4u*)(PROJ + row * DIN + COL_C + c)), cgv); unpack8(__builtin_nontemporal_load((const v4u*)(PROJ + row * DIN + COL_U + c)), u);
            float ss = 0.f;
#pragma unroll
            for (int e = 0; e < 8; ++e) { const float cu = cgv[e] * u[e]; y[e] = bg[e] * (w0[e] * cm2[e] + w1[e] * cm1[e] + w2[e] * cu); cm2[e] = cm1[e]; cm1[e] = cu; ss += y[e] * y[e]; }
            const float rc = 1.0f / sqrtf(wave_sum(ss) * (1.f / CONVD) + EPS);
#pragma unroll
            for (int e = 0; e < 8; ++e) y[e] = y[e] * rc * gc[e];
            *(v4u*)(MIX + row * D + CONVD + c) = pack8(y); }
    }
}

namespace sba {
constexpr float C2 = 0.125f * 1.4426950408889634f;
constexpr int SLOT = 16384, VOFF = 8192, NSLOT = 5, FLAG_OFF = NSLOT * SLOT, STG_OFF = NSLOT * SLOT + 256;
constexpr float THR_EXIT = 48.0f;
__device__ __forceinline__ int crow(int r, int hi) { return (r & 3) + 8 * (r >> 2) + 4 * hi; }
typedef short v4i16_t __attribute__((ext_vector_type(4)));
__device__ __forceinline__ s16x4 vtr(const LAS unsigned char* p) { return __builtin_bit_cast(s16x4, __builtin_amdgcn_ds_read_tr16_b64_v4i16((LAS v4i16_t*)p)); }

__device__ __forceinline__ void attn_unit(int b, int h, int qb, const bf16* PROJ, const float* gq, const float* gk, bf16* MIX, float* ssq_a, LAS unsigned char* lds) {
    const int wid = __builtin_amdgcn_readfirstlane(threadIdx.x >> 6); const int lane = lane_now(), tid = wid * 64 + lane, r32 = lane & 31, hi = lane >> 5;
    const size_t rowbase = (size_t)b * SEQ; const int q0 = qb * 256;
    const int rb = (wid < 4) ? wid : (wid ^ 1);
    const int key_s = tid >> 3, piece = tid & 7;
    const bf16* Kg = PROJ + (rowbase + key_s) * DIN + COL_K + h * HD + piece * 8;
    const bf16* Vg = PROJ + (rowbase + key_s) * DIN + COL_V + h * HD + piece * 8;
    float gkv[8];
#pragma unroll
    for (int e = 0; e < 8; ++e) gkv[e] = gk[piece * 8 + e];
    const int kdst = piece * 1024 + key_s * 16, vdst = VOFF + (piece >> 2) * 4096 + key_s * 64 + (piece & 3) * 16;
    const int ktw = 4 * qb + (rb >> 1);
    f32x16 o0 = {}, o1 = {}; float carry = 0.f;
    const int vrd = VOFF + ((lane >> 4) & 1) * 32 + (lane & 3) * 8 + (4 * hi + ((lane & 15) >> 2)) * 64;
#define SBA_STAGE(KRAW, VRAW, KT) do { float kf[8]; unpack8(KRAW, kf); float ss_ = 0.f; \
        _Pragma("unroll") for (int e = 0; e < 8; ++e) ss_ += kf[e] * kf[e]; \
        ss_ = sum8(ss_); \
        const float rk_ = __builtin_amdgcn_rsqf(ss_ * (1.f / HD) + EPS); \
        _Pragma("unroll") for (int e = 0; e < 8; ++e) kf[e] = kf[e] * rk_ * gkv[e]; \
        const int so_ = ((KT) % NSLOT) * SLOT; *(LAS v4u*)(lds + so_ + kdst) = pack8(kf); *(LAS v4u*)(lds + so_ + vdst) = VRAW; } while (0)
    v4u k4[4], v4[4];
#pragma unroll
    for (int j = 0; j < 4; ++j) { k4[j] = *(const v4u*)(Kg + (size_t)(4 * qb + j) * 64 * DIN); v4[j] = *(const v4u*)(Vg + (size_t)(4 * qb + j) * 64 * DIN); }
    bf16x8 qr[4];
    { const bf16* Qw = PROJ + (rowbase + q0 + rb * 32 + r32) * DIN + COL_Q + h * HD + hi * 8;
      float qf[4][8]; float ss = 0.f;
#pragma unroll
      for (int d0 = 0; d0 < 4; ++d0) { unpack8(*(const v4u*)(Qw + d0 * 16), qf[d0]);
#pragma unroll
          for (int e = 0; e < 8; ++e) ss += qf[d0][e] * qf[d0][e]; }
      { auto rr_ = __builtin_amdgcn_permlane32_swap(__float_as_uint(ss), __float_as_uint(ss), false, false); ss = __uint_as_float(rr_[0]) + __uint_as_float(rr_[1]); }
      const float rq = C2 * __builtin_amdgcn_rsqf(ss * (1.f / HD) + EPS);
#pragma unroll
      for (int d0 = 0; d0 < 4; ++d0) { float t[8];
#pragma unroll
          for (int e = 0; e < 8; ++e) t[e] = qf[d0][e] * rq * gq[d0 * 16 + hi * 8 + e];
          qr[d0] = __builtin_bit_cast(bf16x8, pack8(t)); } }
#pragma unroll
    for (int j = 0; j < 4; ++j) SBA_STAGE(k4[j], v4[j], 4 * qb + j);
    v4u kraw = {}, vraw = {};
    if (qb > 0) { kraw = *(const v4u*)(Kg + (size_t)(4 * qb - 1) * 64 * DIN); vraw = *(const v4u*)(Vg + (size_t)(4 * qb - 1) * 64 * DIN); }
    bool wdone = false;
    for (int s = 0; ; ++s) {
        if (s > 0) { const int n = 4 * qb - s;
            if (n >= 0) SBA_STAGE(kraw, vraw, n);
            if (n >= 1) { kraw = *(const v4u*)(Kg + (size_t)(n - 1) * 64 * DIN); vraw = *(const v4u*)(Vg + (size_t)(n - 1) * 64 * DIN); } }
        __syncthreads();
        if (s > 0) {
            const LAS unsigned* fl = (const LAS unsigned*)(lds + FLAG_OFF) + ((s - 1) & 1) * 8;
            const v4u f0 = *(const LAS v4u*)fl, f1 = *(const LAS v4u*)(fl + 4);
            if (__builtin_amdgcn_readfirstlane((f0.x & f0.y) & (f0.z & f0.w) & (f1.x & f1.y) & (f1.z & f1.w)) != 0u) break; }
        const int kt = ktw - s;
        if (kt >= 0 && !wdone) {
            const int slot = (kt % NSLOT) * SLOT;
            const bool diag = (s == 0); const int qrel = (q0 + rb * 32 + r32) - kt * 64;
#pragma unroll
            for (int blk = 1; blk >= 0; --blk) {
                if (blk == 1 && diag && (rb & 1) == 0) continue;
                if (blk == 0 && wdone) break;
                f32x16 p = {};
                const LAS unsigned char* kb = lds + slot + hi * 1024 + r32 * 16 + blk * 512;
#pragma unroll
                for (int d0 = 0; d0 < 4; ++d0) { const bf16x8 b0 = *(const LAS bf16x8*)(kb + d0 * 2048); p = __builtin_amdgcn_mfma_f32_32x32x16_bf16(b0, qr[d0], p, 0, 0, 0); }
                f32x16 sp;
#pragma unroll
                for (int r = 0; r < 16; ++r) {
                    float z = __builtin_amdgcn_fmed3f(p[r], 64.f, -INFINITY); float t = __builtin_amdgcn_logf(1.0f + __builtin_amdgcn_exp2f(z));
                    if (diag && 32 * blk + crow(r, hi) >= qrel) { t = 0.f; z = -INFINITY; }
                    sp[r] = t; p[r] = z; }
                float pairs[4], Bown[4];
#pragma unroll
                for (int j = 0; j < 4; ++j) {
                    const float own = (sp[4 * j] + sp[4 * j + 1]) + (sp[4 * j + 2] + sp[4 * j + 3]);
                    auto rr = __builtin_amdgcn_permlane32_swap(__float_as_uint(own), __float_as_uint(own), false, false);
                    const float glo = __uint_as_float(rr[0]), ghi = __uint_as_float(rr[1]);
                    pairs[j] = glo + ghi; Bown[j] = hi ? 0.f : ghi; }
                { float base = carry;
#pragma unroll
                  for (int j = 3; j >= 0; --j) { Bown[j] += base; base += pairs[j]; }
                  carry = base; }
#pragma unroll
                for (int j = 0; j < 4; ++j) {
                    float rem = Bown[j] + sp[4 * j + 3];
                    p[4 * j + 3] = __builtin_amdgcn_exp2f(p[4 * j + 3] - rem); rem += sp[4 * j + 2];
                    p[4 * j + 2] = __builtin_amdgcn_exp2f(p[4 * j + 2] - rem); rem += sp[4 * j + 1];
                    p[4 * j + 1] = __builtin_amdgcn_exp2f(p[4 * j + 1] - rem); rem += sp[4 * j + 0];
                    p[4 * j + 0] = __builtin_amdgcn_exp2f(p[4 * j + 0] - rem); }
                v4u pw[2];
                pw[0] = (v4u){cvtpk(p[0], p[1]), cvtpk(p[2], p[3]), cvtpk(p[4], p[5]), cvtpk(p[6], p[7])};
                pw[1] = (v4u){cvtpk(p[8], p[9]), cvtpk(p[10], p[11]), cvtpk(p[12], p[13]), cvtpk(p[14], p[15])};
                const LAS unsigned char* vp = lds + slot + vrd + blk * 2048;
#pragma unroll
                for (int ks = 0; ks < 2; ++ks) {
                    const s16x4 l0 = vtr(vp + ks * 1024), h0 = vtr(vp + ks * 1024 + 512), l1 = vtr(vp + 4096 + ks * 1024), h1 = vtr(vp + 4096 + ks * 1024 + 512);
                    const bf16x8 v0 = (bf16x8){l0[0], l0[1], l0[2], l0[3], h0[0], h0[1], h0[2], h0[3]}, v1 = (bf16x8){l1[0], l1[1], l1[2], l1[3], h1[0], h1[1], h1[2], h1[3]};
                    o0 = __builtin_amdgcn_mfma_f32_32x32x16_bf16(__builtin_bit_cast(bf16x8, pw[ks]), v0, o0, 0, 0, 0);
                    o1 = __builtin_amdgcn_mfma_f32_32x32x16_bf16(__builtin_bit_cast(bf16x8, pw[ks]), v1, o1, 0, 0, 0); }
                wdone = __all(carry >= THR_EXIT);
            }
        }
        { const unsigned fin = (wdone || kt <= 0) ? 1u : 0u; if (lane == 0) ((LAS unsigned*)(lds + FLAG_OFF))[(s & 1) * 8 + wid] = fin; }
    }
#undef SBA_STAGE
    { LAS bf16* stg = (LAS bf16*)(lds + STG_OFF + wid * 4096);
#pragma unroll
      for (int r = 0; r < 16; ++r) { const int orow = crow(r, hi); stg[orow * 64 + r32] = (bf16)f2bf(o0[r]); stg[orow * 64 + 32 + r32] = (bf16)f2bf(o1[r]); }
      LDS_WAIT();
      bf16* Ow = MIX + (rowbase + q0 + rb * 32) * D + h * HD;
#pragma unroll
      for (int i = 0; i < 4; ++i) { const int row = i * 8 + (lane >> 3), ch = lane & 7; const v4u v = *(const LAS v4u*)(stg + row * 64 + ch * 8);
          *(v4u*)(Ow + (size_t)row * D + ch * 8) = v;
          float f[8]; unpack8(v, f); float ss = 0.f;
#pragma unroll
          for (int e = 0; e < 8; ++e) ss += f[e] * f[e];
          ss = sum8(ss);
          if (ch == 0) atomicAdd(ssq_a + rowbase + q0 + rb * 32 + row, ss); } }
    __syncthreads();
}
}

#define XB_TMO      128
#define XB_XCNT(j)  (256  + 64 * (j))
#define XB_XSUB(j)  (1280 + 64 * (j))
#define XB_XGEN(j)  (2304 + 64 * (j))
#define XB_TOP      3328
#define XB_TOPGEN   3392
#define XCD_BAR_WORDS 3456
#define XB_SPIN_CAP (1u << 18)

__device__ __forceinline__ unsigned xb_ld(unsigned* p)              { return __hip_atomic_load(p, __ATOMIC_RELAXED, __HIP_MEMORY_SCOPE_AGENT); }
__device__ __forceinline__ unsigned xb_add(unsigned* p, unsigned v) { return __hip_atomic_fetch_add(p, v, __ATOMIC_RELAXED, __HIP_MEMORY_SCOPE_AGENT); }
__device__ __forceinline__ unsigned xb_xcc_id() { return (unsigned)__builtin_amdgcn_s_getreg((3 << 11) | 20) & 0xFu; }
#define XB_SPIN(cond, bar) do { unsigned _sp = 0; while (cond) { __builtin_amdgcn_s_sleep(1); \
    if ((++_sp & 255u) == 0u) { if (xb_ld(&(bar)[XB_TMO])) break; if (_sp > XB_SPIN_CAP) { atomicAdd(&(bar)[XB_TMO], 1u); break; } } } } while (0)

struct XcdBarrier {
    unsigned* bar; unsigned x;
    volatile LAS unsigned* st;
};

__device__ __forceinline__ XcdBarrier xcd_barrier_post(unsigned* bar, volatile LAS unsigned* st) {
    XcdBarrier b; b.bar = bar; b.x = xb_xcc_id(); b.st = st;
    if (threadIdx.x == 0) (void)xb_add(&bar[XB_XCNT(b.x)], 1u);
    return b;
}
__device__ __forceinline__ void xcd_barrier_complete(unsigned* bar, unsigned x, unsigned& nloc, unsigned& nx) {
    const unsigned G = gridDim.x * gridDim.y * gridDim.z;
    unsigned sum, cnt, mine, sp = 0u;
    for (;;) {
        sum = 0u; cnt = 0u; mine = 0u;
#pragma unroll
        for (unsigned j = 0; j < 16; ++j) { const unsigned c = xb_ld(&bar[XB_XCNT(j)]); sum += c; cnt += (c > 0u) ? 1u : 0u; mine = (j == x) ? c : mine; }
        if (sum == G) break;
        __builtin_amdgcn_s_sleep(1);
        if ((++sp & 255u) == 0u) { if (xb_ld(&bar[XB_TMO])) break; if (sp > XB_SPIN_CAP) { atomicAdd(&bar[XB_TMO], 1u); break; } }
    }
    nloc = mine > 0u ? mine : 1u; nx = cnt > 0u ? cnt : 1u;
}

__device__ __forceinline__ void xcd_barrier(const XcdBarrier& b, bool local = false) {
    asm volatile("s_waitcnt vmcnt(0)" ::: "memory");
    __syncthreads();
    if (threadIdx.x == 0) {
        unsigned* bar = b.bar;
        __builtin_amdgcn_s_waitcnt(0);
        unsigned nloc = b.st[0], nx = b.st[1];
        if (nloc == 0u) { xcd_barrier_complete(bar, b.x, nloc, nx); b.st[0] = nloc; b.st[1] = nx; }
        const unsigned old = xb_add(&bar[XB_XSUB(b.x)], 1u);
        const unsigned gen = old / nloc;
        if (old + 1u == (gen + 1u) * nloc) {
            if (!local) __builtin_amdgcn_fence(__ATOMIC_RELEASE, "agent");
            asm volatile("s_waitcnt vmcnt(0)" ::: "memory");
            if (!local) {
            const unsigned og = xb_add(&bar[XB_TOP], 1u);
            const unsigned tg = og / nx;
            if (og + 1u == (tg + 1u) * nx) xb_add(&bar[XB_TOPGEN], 1u);
            else XB_SPIN(xb_ld(&bar[XB_TOPGEN]) == tg, bar);
            }
            __builtin_amdgcn_fence(__ATOMIC_ACQUIRE, "agent");
            xb_add(&bar[XB_XGEN(b.x)], 1u);
            asm volatile("s_waitcnt vmcnt(0)" ::: "memory");
        } else {
            __builtin_amdgcn_fence(__ATOMIC_ACQUIRE, "agent");
            XB_SPIN(xb_ld(&bar[XB_XGEN(b.x)]) == gen, bar);
            asm volatile("" ::: "memory");
            asm volatile("s_waitcnt vmcnt(0)" ::: "memory");
        }
    }
    __syncthreads();
}

#ifndef PROBE_DUP
#define PROBE_DUP (-1)
#endif
#ifndef SEAM_LOCAL_ENABLE
#define SEAM_LOCAL_ENABLE 1
#endif
struct Args { const float* in[15]; float* out; unsigned char* ws; int ph_lo, ph_hi, coop, pad; };
constexpr int N_PHASES = 7;
__global__ void __launch_bounds__(NWAVES * 64, 2) mk_fwd(Args args) {
    extern __shared__ __attribute__((aligned(16))) unsigned char lds_raw[];
    LAS unsigned char* lds = (LAS unsigned char*)lds_raw;
    const int wave = __builtin_amdgcn_readfirstlane(threadIdx.x >> 6);
#define tid (wave * 64 + lane_now())
#define lane lane_now()
    const int G = gridDim.x; const int bx = blockIdx.x; const int vcu = (G % 8 == 0) ? (bx % 8) * (G / 8) + bx / 8 : bx;
    const int gw = vcu * NWAVES + wave, NGW = G * NWAVES;
    const float* x = args.in[0]; const float* cvec = args.in[1]; const float* wada = args.in[2]; const float* bada = args.in[3]; const float* g1 = args.in[4];
    const float* win = args.in[5]; const float* convw = args.in[6]; const float* gq = args.in[7]; const float* gk = args.in[8]; const float* gconv = args.in[9];
    const float* gattn = args.in[10]; const float* wout = args.in[11]; const float* g2 = args.in[12]; const float* wff1 = args.in[13]; const float* wff2 = args.in[14];
    float* out = args.out; unsigned char* ws = args.ws;
    float* modacc = (float*)(ws + WS_CTL);
    bf16* Win_t = (bf16*)(ws + WS_WIN); bf16* Wo_t = (bf16*)(ws + WS_WO); bf16* W1_t = (bf16*)(ws + WS_W1); bf16* W2_t = (bf16*)(ws + WS_W2);
    bf16* PROJ = (bf16*)(ws + WS_PROJ); bf16* MIX = (bf16*)(ws + WS_MIX); bf16* HB = (bf16*)(ws + WS_H); bf16* XN = (bf16*)(ws + WS_XN); bf16* X1B = (bf16*)(ws + WS_X1B);
    const int lo = args.ph_lo, hi = args.ph_hi;
    volatile LAS unsigned* MISC = (volatile LAS unsigned*)(lds + MISC_OFF);
    if (tid < 32) MISC[tid] = 0u;
    __syncthreads();
    XcdBarrier bar; bar.bar = (unsigned*)(ws + WS_BAR); bar.x = 0; bar.st = nullptr;
    if (args.coop) bar = xcd_barrier_post((unsigned*)(ws + WS_BAR), MISC + 8);
    unsigned* cen = (unsigned*)(ws + WS_CEN);
    if (args.coop && G == 256 && threadIdx.x == 0) { const unsigned xc = xb_xcc_id(); atomicMax(&cen[vcu >> 5], xc + 1u); atomicMax(&cen[8 + (vcu >> 5)], 16u - xc); }
    int seam_local = 0;
#define IN(k) (lo <= (k) && (k) < hi)
#define SEAM(k) do { if (IN(k) && IN((k) + 1)) { xcd_barrier(bar, (k) > 0 && seam_local != 0); } } while (0)

    float* ssq_a = (float*)(ws + WS_SSQA); float* ssq2 = (float*)(ws + WS_SSQ2); float* sbv = (float*)(ws + WS_SB);
    float* scrf = (float*)(ws + 224 * MiB);
    const int alt = args.pad;
    if (IN(0)) {
        LAS float* scr = (LAS float*)(lds + wave * 16384);
        constexpr int I_IN = (D / 64) * (DIN / 32), I_O = (D / 64) * (D / 32), I_1 = (D / 64) * (FF / 32), I_2 = (FF / 64) * (D / 32), I_G = 16 * 96;
        constexpr int NITEMS = I_G + I_IN + I_O + I_1 + I_2;
        for (int it = gw; it < NITEMS; it += NGW) {
            int r = it;
            if (r < I_G) { p0_gemv_item(cvec, wada, alt ? scrf : modacc, r, lane); continue; } r -= I_G;
            if (r < I_IN) { p0_transpose_item(win, D, DIN, Win_t, scr, r, lane); continue; } r -= I_IN;
            if (r < I_O) { p0_transpose_wo_item(wout, gattn, Wo_t, scr, r, lane); continue; } r -= I_O;
            if (r < I_1) { p0_transpose_item(wff1, D, FF, W1_t, scr, r, lane); continue; } r -= I_1;
            p0_transpose_item(wff2, FF, D, W2_t, scr, r, lane);
        }
    }
    SEAM(0);
    if (args.coop && G == 256) { unsigned ok = 1u;
#pragma unroll
        for (int g_ = 0; g_ < 8; ++g_) { const unsigned a_ = xb_ld(&cen[g_]), b_ = xb_ld(&cen[8 + g_]); ok &= (a_ != 0u && a_ - 1u == 16u - b_) ? 1u : 0u; }
        seam_local = (int)__builtin_amdgcn_readfirstlane(ok) & SEAM_LOCAL_ENABLE; }
    if (IN(1)) { LAS float* sh = (LAS float*)lds;
        if (G == 256) {
            const int bg = vcu >> 5;
            for (int i = tid; i < D; i += NWAVES * 64) sh[i] = modacc[bg * NMOD + 3 * D + i] + bada[3 * D + i];
            __syncthreads();
            for (int n = (vcu & 31) * NWAVES + wave; n < FF; n += 32 * NWAVES) p1_sb_row1(sh, W1_t, sbv + bg * FF, n, lane);
        } else {
        for (int i = tid; i < 8 * D; i += NWAVES * 64) sh[i] = modacc[(i >> 10) * NMOD + 3 * D + (i & 1023)] + bada[3 * D + (i & 1023)];
        __syncthreads();
        for (int n = gw; n < FF; n += NGW) p1_sb_row(sh, W1_t, sbv, n, lane);
        }
        norm_mod_pass(x, g1, modacc, bada, 0, 1, XN, gw, NGW, lane);
        __syncthreads(); }
    SEAM(1);
    if (IN(2)) { pg8::Gemm g{XN, Win_t, M, DIN, D}; pg8::StaticOrder S; S.init(M, DIN, G, bx); pg8::EpiStore<0> E{PROJ, DIN};
        pg8::gemm_phase<pg8::EpiStore<0>, pg8::StaticOrder, true, true>(lds, g, S, E); }
    SEAM(2);
    if (IN(3)) { for (int j = vcu; j < 512; j += G) { const int jj = j & 255, bh = jj >> 2, s = jj & 3, qb = (j < 256) ? s : 7 - s;
            sba::attn_unit(bh >> 3, bh & 7, qb, PROJ, gq, gk, MIX, alt ? scrf : ssq_a, lds); }
        conv_norm_pass(PROJ, convw, gconv, MIX, gw, NGW, lane); }
    SEAM(3);
    if (IN(4)) { pg8::Gemm g{MIX, Wo_t, M, D, D}; pg8::StaticOrder S; S.init(M, D, G, bx); pg8::EpiWo E{x, X1B, XN, modacc, bada, g2, ssq_a, alt ? scrf : ssq2, lds};
        { pg8::Unit u0; if (S.next(0, u0)) E.pre(u0, 0, tid); __syncthreads(); }
        pg8::gemm_phase<pg8::EpiWo, pg8::StaticOrder, false, true>(lds, g, S, E); }
    SEAM(4);
    if (IN(5)) { pg8::Gemm g{XN, W1_t, M, FF, D}; pg8::StaticOrder S; S.init(M, FF, G, bx); pg8::EpiUp E{HB, ssq2, sbv};
        pg8::gemm_phase<pg8::EpiUp, pg8::StaticOrder, true, true>(lds, g, S, E); }
    SEAM(5);
    if (IN(6)) { pg8::Gemm g{HB, W2_t, M, D, FF}; pg8::StaticOrder S; S.init(M, D, G, bx); pg8::EpiResGate E{X1B, alt ? scrf : out, modacc, bada, 5 * D, lds};
        { pg8::Unit u0; if (S.next(0, u0)) E.pre(u0, 0, tid); __syncthreads(); }
        pg8::gemm_phase<pg8::EpiResGate, pg8::StaticOrder, false, true>(lds, g, S, E); }
#undef IN
#undef SEAM
#undef tid
#undef lane
}

#ifndef MK_SPLIT
#define MK_SPLIT 0
#endif
extern "C" void kernel_launch(void* const* d_in, const int* in_sizes, int n_in, void* d_out, int out_size, void* d_ws, size_t ws_size, hipStream_t stream) {
    static int grid = 0;
    if (grid == 0) {
        int dev = 0, cus = 0, per_cu = 0;
        if (n_in != 15 || out_size != M * D || ws_size < WS_END) { fprintf(stderr, "kernel_launch: unexpected shapes\n"); grid = -1; return; }
        hipGetDevice(&dev); hipDeviceGetAttribute(&cus, hipDeviceAttributeMultiprocessorCount, dev);
        if (hipFuncSetAttribute((const void*)mk_fwd, hipFuncAttributeMaxDynamicSharedMemorySize, LDS_BYTES) != hipSuccess) { fprintf(stderr, "kernel_launch: hipFuncSetAttribute failed\n"); grid = -1; return; }
        if (hipOccupancyMaxActiveBlocksPerMultiprocessor(&per_cu, (const void*)mk_fwd, NWAVES * 64, LDS_BYTES) != hipSuccess || per_cu < 1) { fprintf(stderr, "kernel_launch: the occupancy query reports %d resident workgroups per CU for this kernel; a grid-wide barrier needs at least 1; nothing launched\n", per_cu); grid = -1; return; }
        (void)hipGetLastError();
        if (cus != 256) { fprintf(stderr, "kernel_launch: built for a 256-CU device (one 256x256 unit per workgroup in the N=1024 GEMM phases); got %d CUs\n", cus); grid = -1; return; }
        grid = cus * (per_cu < 1 ? per_cu : 1);
    }
    if (grid < 0) return;
    (void)hipMemsetAsync((char*)d_ws + WS_CTL, 0, CTL_ZERO_BYTES, stream);
    Args a{};
    for (int i = 0; i < 15; ++i) a.in[i] = (const float*)d_in[i];
    a.out = (float*)d_out; a.ws = (unsigned char*)d_ws;
#if MK_SPLIT
    for (int p = 0; p < N_PHASES; ++p) { a.ph_lo = p; a.ph_hi = p + 1; a.coop = 0; a.pad = 0; hipLaunchKernelGGL(mk_fwd, dim3(grid), dim3(NWAVES * 64), LDS_BYTES, stream, a);
        if (p == PROBE_DUP) { a.pad = 1; hipLaunchKernelGGL(mk_fwd, dim3(grid), dim3(NWAVES * 64), LDS_BYTES, stream, a); } }
#else
    a.ph_lo = 0; a.ph_hi = N_PHASES; a.coop = 1;
    void* kargs[] = {&a};
    hipError_t e = hipLaunchCooperativeKernel((const void*)mk_fwd, dim3(grid), dim3(NWAVES * 64), kargs, LDS_BYTES, stream);
    if (e != hipSuccess) fprintf(stderr, "kernel_launch: cooperative launch failed: %s (grid %d)\n", hipGetErrorString(e), grid);
#endif
}
```

```cpp
#include <hip/hip_runtime.h>
#include <hip/hip_cooperative_groups.h>
#include <cstdio>
#include <cstdint>
namespace cg = cooperative_groups;
__device__ __forceinline__ int lane_now() { int l; asm volatile("v_mbcnt_lo_u32_b32 %0, -1, 0\n\tv_mbcnt_hi_u32_b32 %0, -1, %0" : "=v"(l)); return l; }
namespace pg8 {
#define PG8_LAS __attribute__((address_space(3)))
typedef unsigned short bf16_t;
typedef short bf16x8 __attribute__((ext_vector_type(8)));
typedef float f32x4 __attribute__((ext_vector_type(4)));
typedef unsigned u32x4 __attribute__((ext_vector_type(4)));
constexpr int BM = 256, BK = 64, HALF = 128, HTB = HALF * BK * 2  , STAGE_BYTES = 8 * HTB, NXCD = 8, WGM = 8;

__host__ __device__ __forceinline__ int lds_byte(int r, int c) { const int st = (r >> 4) * 2 + (c >> 5), rr = r & 15, cc = c & 31, ob = rr * 64 + cc * 2; return st * 1024 + (ob ^ (((ob >> 9) & 1) << 5)); }
__host__ __device__ __forceinline__ void stage_rc(int b, int& R, int& C) { const int st = b / 1024, sb = b % 1024, swz = sb ^ (((sb >> 9) & 1) << 5); R = (st >> 1) * 16 + swz / 64; C = (st & 1) * 32 + (swz % 64) / 2; }
__host__ __device__ __forceinline__ int perm32(int rho) { const int n = rho >> 4, i = rho & 15; return 8 * (i >> 2) + 4 * n + (i & 3); }

struct Unit { int pm, pn; };
struct Gemm { const bf16_t* A; const bf16_t* Bt; int M, N, K; };

struct StaticOrder {
    int nM, nN, nwg, G, c;
    __host__ __device__ void init(int M, int N, int G_, int c_) { nM = M / BM; nN = N / BM; nwg = nM * nN; G = G_; c = c_; }
    __host__ __device__ bool next(int i, Unit& u) const {
        const long L = (long)i * G + c; if (L >= nwg) return false;
        int wgid = (int)L; { const int q = nwg / NXCD, r = nwg % NXCD, xcd = wgid % NXCD, off = wgid / NXCD; wgid = (xcd < r ? xcd * (q + 1) : r * (q + 1) + (xcd - r) * q) + off; }
        const int nig = WGM * nN, gid = wgid / nig, fm = gid * WGM, gsz = (nM - fm) < WGM ? (nM - fm) : WGM;
        u.pm = fm + ((wgid % nig) % gsz); u.pn = (wgid % nig) / gsz; return true;
    }
    __device__ __forceinline__ void a_ready(const Unit&) const {}
    __device__ __forceinline__ void done(const Unit&) const {}
};

__device__ __forceinline__ unsigned cvt_pk_bf16(float lo, float hi) { unsigned r; asm volatile("v_cvt_pk_bf16_f32 %0, %1, %2" : "=v"(r) : "v"(lo), "v"(hi)); return r; }
typedef float f32x2 __attribute__((ext_vector_type(2)));
__device__ __forceinline__ f32x2 gelu_pk(f32x2 v) {
    const f32x2 av = __builtin_elementwise_abs(v), d = av * 0.2316418882f + 1.0f;
    f32x2 t; t.x = __builtin_amdgcn_rcpf(d.x); t.y = __builtin_amdgcn_rcpf(d.y);
    f32x2 q = t * 0.5307027145f + (-0.7265760135f); q = q * t + 0.7107068705f; q = q * t + (-0.142248368f); q = q * t + 0.127414796f; q = q * t;
    const f32x2 s = (v * v) * (-0.72134752044f);
    f32x2 e; e.x = __builtin_amdgcn_exp2f(s.x); e.y = __builtin_amdgcn_exp2f(s.y);
    const f32x2 m = v * (q * e), r = v - m;
    f32x2 o; o.x = v.x < 0.f ? m.x : r.x; o.y = v.y < 0.f ? m.y : r.y; return o;
}

template <int ACT  > struct EpiBf16 {
    static constexpr bool PERM = true, AFTER_DRAIN = false; static_assert(ACT == 0 || ACT == 1, "EpiBf16: ACT is 0 (none) or 1 (gelu_pk)");
    bf16_t* O; int ldc; const float* bias; int split_cols; size_t split_stride; float scale0;
    __device__ __forceinline__ void operator()(const f32x4 (&acc)[2][2][4][2], const Unit& u, int wr, int wc, int fr, int fq) const {
        const int row0 = u.pm * BM + wr * 64 + fr; int colt = u.pn * BM; bf16_t* base = O;
        float sc = 1.f; if (split_cols) { const int t = colt / split_cols; base += (size_t)t * split_stride; colt -= t * split_cols; if (t == 0) sc = scale0; }
        const int col0 = colt + wc * 32 + 8 * fq, bcol0 = u.pn * BM + wc * 32 + 8 * fq;
        f32x4 bv[2][2];
#pragma unroll
        for (int bj = 0; bj < 2; ++bj)
#pragma unroll
            for (int n = 0; n < 2; ++n) bv[bj][n] = bias ? *(const f32x4*)(bias + bcol0 + bj * HALF + 4 * n) : (f32x4){0.f, 0.f, 0.f, 0.f};
#pragma unroll
        for (int ai = 0; ai < 2; ++ai)
#pragma unroll
            for (int m = 0; m < 4; ++m) { bf16_t* rowp = base + (size_t)(row0 + ai * HALF + m * 16) * ldc + col0;
#pragma unroll
                for (int bj = 0; bj < 2; ++bj) { f32x4 v0 = acc[ai][bj][m][0] + bv[bj][0], v1 = acc[ai][bj][m][1] + bv[bj][1];
                    if (ACT == 1) { f32x2 a = gelu_pk((f32x2){v0[0], v0[1]}), b = gelu_pk((f32x2){v0[2], v0[3]}), c = gelu_pk((f32x2){v1[0], v1[1]}), d = gelu_pk((f32x2){v1[2], v1[3]});
                        v0 = (f32x4){a.x, a.y, b.x, b.y}; v1 = (f32x4){c.x, c.y, d.x, d.y}; }
                    v0 = v0 * sc; v1 = v1 * sc; u32x4 w; w.x = cvt_pk_bf16(v0[0], v0[1]); w.y = cvt_pk_bf16(v0[2], v0[3]); w.z = cvt_pk_bf16(v1[0], v1[1]); w.w = cvt_pk_bf16(v1[2], v1[3]);
                    *(u32x4*)(rowp + bj * HALF) = w; } }
    }
};
template <int ACT> struct EpiStore {
    static constexpr bool PERM = true, AFTER_DRAIN = false, MIDK = false, SCALE = false;
    bf16_t* O; int ldc;
    __device__ __forceinline__ void operator()(const f32x4 (&acc)[2][2][4][2], const Unit& u, int ui, int wr, int wc, int fr, int fq) const {
        const int row0 = u.pm * BM + wr * 64 + fr; const int col0 = u.pn * BM + wc * 32 + 8 * fq;
#pragma unroll
        for (int ai = 0; ai < 2; ++ai)
#pragma unroll
            for (int m = 0; m < 4; ++m) { bf16_t* rowp = O + (size_t)(row0 + ai * HALF + m * 16) * ldc + col0;
#pragma unroll
                for (int bj = 0; bj < 2; ++bj) { f32x4 v0 = acc[ai][bj][m][0], v1 = acc[ai][bj][m][1];
                    if (ACT == 2) {
#pragma unroll
                        for (int e = 0; e < 4; ++e) { float a = fmaxf(v0[e], 0.f), b = fmaxf(v1[e], 0.f); v0[e] = a * a; v1[e] = b * b; } }
                    u32x4 w; w.x = cvt_pk_bf16(v0[0], v0[1]); w.y = cvt_pk_bf16(v0[2], v0[3]); w.z = cvt_pk_bf16(v1[0], v1[1]); w.w = cvt_pk_bf16(v1[2], v1[3]);
                    *(u32x4*)(rowp + bj * HALF) = w; } }
    }
};
#define PG8_TAB(lds, par) ((PG8_LAS float*)((lds) + 132096 + (par) * 3072))
struct EpiResGate {
    static constexpr bool PERM = false, AFTER_DRAIN = false, MIDK = false, SCALE = false;
    const bf16_t* base; float* out; const float* modacc; const float* bada; int goff; PG8_LAS unsigned char* lds;
    __device__ __forceinline__ void pre(const Unit& u, int ui, int tid_) const { int tid = tid_; asm volatile("" : "+v"(tid));
        if (tid < 256) { const int c = goff + u.pn * BM + tid; PG8_TAB(lds, 0)[256 + tid] = modacc[(u.pm >> 3) * 6144 + c] + bada[c]; }
    }
    __device__ __forceinline__ void operator()(const f32x4 (&acc)[2][2][4][2], const Unit& u, int ui, int wr, int wc, int fr, int fq) const {
        typedef unsigned u32x2v __attribute__((ext_vector_type(2)));
        const PG8_LAS float* tab = PG8_TAB(lds, 0) + 256;
        const int cl0 = wc * 32 + 4 * fq; const size_t off0 = (size_t)(u.pm * BM + wr * 64 + fr) * 1024 + u.pn * BM + cl0;
        u32x2v xb[2][8];
#define PG8_LDX(g, buf) do { _Pragma("unroll") for (int q_ = 0; q_ < 8; ++q_) xb[buf][q_] = *(const u32x2v*)(base + off0 + (size_t)((q_ >> 2) * HALF + (q_ & 3) * 16) * 1024 + ((g) >> 1) * HALF + ((g) & 1) * 16); } while (0)
        PG8_LDX(0, 0);
#pragma unroll
        for (int g = 0; g < 4; ++g) { const int bj = g >> 1, n = g & 1;
            if (g < 3) PG8_LDX(g + 1, (g + 1) & 1);
            const f32x4 gv = *(const PG8_LAS f32x4*)(tab + cl0 + bj * HALF + n * 16);
#pragma unroll
            for (int q = 0; q < 8; ++q) { const int ai = q >> 2, m = q & 3; const u32x2v w = xb[g & 1][q];
                const f32x4 bs = {__builtin_bit_cast(float, w.x << 16), __builtin_bit_cast(float, w.x & 0xffff0000u), __builtin_bit_cast(float, w.y << 16), __builtin_bit_cast(float, w.y & 0xffff0000u)};
                __builtin_nontemporal_store(bs + gv * acc[ai][bj][m][n], (f32x4*)(out + off0 + (size_t)(ai * HALF + m * 16) * 1024 + bj * HALF + n * 16)); } }
#undef PG8_LDX
    }
};
struct EpiWo {
    static constexpr bool PERM = false, AFTER_DRAIN = false, MIDK = false, SCALE = true;
    const float* base; bf16_t* x1b; bf16_t* xn; const float* modacc; const float* bada; const float* g2; const float* ssq_a; float* ssq2; PG8_LAS unsigned char* lds;
    __device__ __forceinline__ void pre(const Unit& u, int ui, int tid_) const { int tid = tid_; asm volatile("" : "+v"(tid));
        PG8_LAS float* tab = PG8_TAB(lds, 0);
        if (tid < 256) { const int c = u.pn * BM + tid, b = u.pm >> 3;
            tab[256 + tid] = modacc[b * 6144 + 2048 + c] + bada[2048 + c];
            tab[512 + tid] = g2[c] * (modacc[b * 6144 + 4096 + c] + bada[4096 + c] + 1.0f); }
        else tab[tid - 256] = 1.0f / sqrtf(ssq_a[u.pm * BM + tid - 256] * (1.f / 512.f) + 1e-6f);
    }
    __device__ __forceinline__ void mid(f32x4 (&acc)[2][2][4][2], const Unit& u, int ui, int wr, int wc, int fr, int fq) const {
        const PG8_LAS float* tab = PG8_TAB(lds, 0); int frp = fr; asm volatile("" : "+v"(frp));
#pragma unroll
        for (int ai = 0; ai < 2; ++ai)
#pragma unroll
            for (int m = 0; m < 4; ++m) { const float ra = tab[ai * HALF + wr * 64 + m * 16 + frp];
#pragma unroll
                for (int bj = 0; bj < 2; ++bj)
#pragma unroll
                    for (int n = 0; n < 2; ++n) acc[ai][bj][m][n] *= ra; }
    }
    __device__ __forceinline__ void operator()(const f32x4 (&acc)[2][2][4][2], const Unit& u, int ui, int wr, int wc, int fr, int fq) const {
        typedef unsigned u32x2v __attribute__((ext_vector_type(2)));
        const PG8_LAS float* tab = PG8_TAB(lds, 0);
        const int cl0 = wc * 32 + 4 * fq; const int rowb = u.pm * BM + wr * 64 + fr; const size_t off0 = (size_t)rowb * 1024 + u.pn * BM + cl0;
        float ss[8];
#pragma unroll
        for (int q = 0; q < 8; ++q) ss[q] = 0.f;
        f32x4 xb[2][4];
#define PG8_LDX(g, buf) do { _Pragma("unroll") for (int q_ = 0; q_ < 4; ++q_) xb[buf][q_] = __builtin_nontemporal_load((const f32x4*)(base + off0 + (size_t)(((g) & 1) * HALF + q_ * 16) * 1024 + ((g) >> 2) * HALF + (((g) >> 1) & 1) * 16)); } while (0)
        PG8_LDX(0, 0);
#pragma unroll
        for (int g = 0; g < 8; ++g) { const int bj = g >> 2, n = (g >> 1) & 1, ai = g & 1;
            if (g < 7) PG8_LDX(g + 1, (g + 1) & 1);
            const f32x4 gv = *(const PG8_LAS f32x4*)(tab + 256 + cl0 + bj * HALF + n * 16), av = *(const PG8_LAS f32x4*)(tab + 512 + cl0 + bj * HALF + n * 16);
#pragma unroll
            for (int m = 0; m < 4; ++m) { const size_t off = off0 + (size_t)(ai * HALF + m * 16) * 1024 + bj * HALF + n * 16;
                const f32x4 x1 = xb[g & 1][m] + gv * acc[ai][bj][m][n];
                u32x2v w; w.x = cvt_pk_bf16(x1[0], x1[1]); w.y = cvt_pk_bf16(x1[2], x1[3]);
                *(u32x2v*)(x1b + off) = w;
                ss[ai * 4 + m] += (x1[0] * x1[0] + x1[1] * x1[1]) + (x1[2] * x1[2] + x1[3] * x1[3]);
                const f32x4 y = x1 * av; w.x = cvt_pk_bf16(y[0], y[1]); w.y = cvt_pk_bf16(y[2], y[3]);
                *(u32x2v*)(xn + off) = w; } }
#undef PG8_LDX
#pragma unroll
        for (int q = 0; q < 8; ++q) { float s = ss[q]; s += __shfl_xor(s, 16); s += __shfl_xor(s, 32);
            if (fq == 0) atomicAdd(ssq2 + rowb + (q >> 2) * HALF + (q & 3) * 16, s); }
    }
};
struct EpiUp {
    static constexpr bool PERM = true, AFTER_DRAIN = false, MIDK = false, SCALE = false;
    bf16_t* O; const float* ssq2; const float* sb;
    __device__ __forceinline__ void operator()(const f32x4 (&acc)[2][2][4][2], const Unit& u, int ui, int wr, int wc, int fr, int fq) const {
        const int b = u.pm >> 3; const int row0 = u.pm * BM + wr * 64 + fr; const int col0 = u.pn * BM + wc * 32 + 8 * fq;
        f32x4 sv[2][2]; float rv[2][4];
#pragma unroll
        for (int ai = 0; ai < 2; ++ai)
#pragma unroll
            for (int m = 0; m < 4; ++m) rv[ai][m] = ssq2[row0 + ai * HALF + m * 16];
#pragma unroll
        for (int bj = 0; bj < 2; ++bj)
#pragma unroll
            for (int n = 0; n < 2; ++n) sv[bj][n] = *(const f32x4*)(sb + b * 4096 + col0 + bj * HALF + 4 * n);
#pragma unroll
        for (int ai = 0; ai < 2; ++ai)
#pragma unroll
            for (int m = 0; m < 4; ++m) { const int row = row0 + ai * HALF + m * 16; const float rinv = 1.0f / sqrtf(rv[ai][m] * (1.f / 1024.f) + 1e-6f);
                bf16_t* rowp = O + (size_t)row * 4096 + col0;
#pragma unroll
                for (int bj = 0; bj < 2; ++bj) { f32x4 v0 = acc[ai][bj][m][0] * rinv + sv[bj][0], v1 = acc[ai][bj][m][1] * rinv + sv[bj][1];
#pragma unroll
                    for (int e = 0; e < 4; ++e) { const float a = fmaxf(v0[e], 0.f), c = fmaxf(v1[e], 0.f); v0[e] = a * a; v1[e] = c * c; }
                    u32x4 w; w.x = cvt_pk_bf16(v0[0], v0[1]); w.y = cvt_pk_bf16(v0[2], v0[3]); w.z = cvt_pk_bf16(v1[0], v1[1]); w.w = cvt_pk_bf16(v1[2], v1[3]);
                    *(u32x4*)(rowp + bj * HALF) = w; } }
    }
};
template <class Epi, class Sched, bool ALIGN_EPI = false, bool SP2 = false>
__device__ __forceinline__ void gemm_phase(PG8_LAS unsigned char* lds, const Gemm g, const Sched& S, const Epi& E) {
    const int wid = __builtin_amdgcn_readfirstlane(threadIdx.x >> 6), lane = lane_now(), tid = wid * 64 + lane, wr = wid >> 2, wc = wid & 3, fr = lane & 15, fq = lane >> 4;
    const int K = g.K, nt = K / BK;
    unsigned voffA[2], voffB[2];
#pragma unroll
    for (int i = 0; i < 2; ++i) { int R, C; stage_rc(tid * 16 + i * 8192, R, C); const int Rb = Epi::PERM ? ((R & ~31) + perm32(R & 31)) : R;
        voffA[i] = (unsigned)(R * K + C) * 2u; voffB[i] = (unsigned)(Rb * K + C) * 2u; }
    const size_t kstep = (size_t)(BK * 2);
    const size_t hstep = (size_t)HALF * K * 2;
    const size_t tstep = 2 * hstep;
    const unsigned ldsw = (unsigned)wid * 1024u;
    const int aoff = lds_byte(wr * 64 + fr, fq * 8), boff = lds_byte(wc * 32 + fr, fq * 8);
#define PG8_SA(b, h) (((b) * 2 + (h)) * HTB)
#define PG8_SB(b, h) ((4 + (b) * 2 + (h)) * HTB)
#define PG8_STAGE(bufoff, gbase, voff) do { _Pragma("unroll") for (int _i = 0; _i < 2; ++_i) \
        __builtin_amdgcn_global_load_lds((const unsigned*)((const char*)(gbase) + (voff)[_i]), (PG8_LAS unsigned*)(lds + (bufoff) + ldsw + _i * 8192), 16, 0, 0); } while (0)
#define PG8_LDA(dst, b, h) do { _Pragma("unroll") for (int m = 0; m < 4; ++m) _Pragma("unroll") for (int k = 0; k < 2; ++k) dst[m][k] = *(const PG8_LAS bf16x8*)(lds + PG8_SA(b, h) + aoff + m * 2048 + k * 1024); } while (0)
#define PG8_LDB(dst, b, h) do { _Pragma("unroll") for (int n = 0; n < 2; ++n) _Pragma("unroll") for (int k = 0; k < 2; ++k) dst[n][k] = *(const PG8_LAS bf16x8*)(lds + PG8_SB(b, h) + boff + n * 2048 + k * 1024); } while (0)
#define PG8_MMA(ai, bj, At, Bt) do { __builtin_amdgcn_s_setprio(1); _Pragma("unroll") for (int m = 0; m < 4; ++m) _Pragma("unroll") for (int n = 0; n < 2; ++n) _Pragma("unroll") for (int k = 0; k < 2; ++k) \
        acc[ai][bj][m][n] = __builtin_amdgcn_mfma_f32_16x16x32_bf16(Bt[n][k], At[m][k], acc[ai][bj][m][n], 0, 0, 0); __builtin_amdgcn_s_setprio(0); } while (0)
#define PG8_WAIT_V(n) asm volatile("s_waitcnt vmcnt(" #n ")" ::: "memory")
#define PG8_WAIT_L(n) asm volatile("s_waitcnt lgkmcnt(" #n ")" ::: "memory")
#define PG8_BAR __builtin_amdgcn_s_barrier()
#define PG8_SCHED __builtin_amdgcn_sched_barrier(0)
    Unit cur, nxt; int ui = 0;
    if (!S.next(0, cur)) return;
    f32x4 acc[2][2][4][2];
#pragma unroll
    for (int a = 0; a < 2; ++a)
#pragma unroll
        for (int b = 0; b < 2; ++b)
#pragma unroll
            for (int m = 0; m < 4; ++m)
#pragma unroll
                for (int n = 0; n < 2; ++n) acc[a][b][m][n] = (f32x4){0.f, 0.f, 0.f, 0.f};
    bf16x8 At[4][2], B0[2][2], B1[2][2];
    const char* cA = (const char*)g.A + (size_t)cur.pm * tstep; const char* cB = (const char*)g.Bt + (size_t)cur.pn * tstep;
    S.a_ready(cur);
    if constexpr (SP2) {
        PG8_STAGE(PG8_SB(0, 0), cB, voffB); PG8_STAGE(PG8_SB(0, 1), cB + hstep, voffB); PG8_STAGE(PG8_SA(0, 0), cA, voffA); PG8_STAGE(PG8_SA(0, 1), cA + hstep, voffA);
        if (wr == 1) PG8_BAR;
        PG8_WAIT_V(2); PG8_BAR;
        PG8_STAGE(PG8_SB(1, 0), cB + kstep, voffB); PG8_STAGE(PG8_SA(1, 0), cA + kstep, voffA); PG8_STAGE(PG8_SB(1, 1), cB + hstep + kstep, voffB);
        PG8_WAIT_V(6); PG8_BAR;
    } else {
        PG8_STAGE(PG8_SB(0, 0), cB, voffB); PG8_STAGE(PG8_SA(0, 0), cA, voffA); PG8_STAGE(PG8_SB(0, 1), cB + hstep, voffB); PG8_STAGE(PG8_SA(0, 1), cA + hstep, voffA);
        if (wr == 1) PG8_BAR;
        PG8_WAIT_V(4); PG8_BAR;
        PG8_STAGE(PG8_SB(1, 0), cB + kstep, voffB); PG8_STAGE(PG8_SA(1, 0), cA + kstep, voffA); PG8_STAGE(PG8_SB(1, 1), cB + hstep + kstep, voffB);
        PG8_WAIT_V(6); PG8_BAR;
    }
    for (;;) {
        const bool has_next = S.next(ui + 1, nxt);
        const char* nA = has_next ? (const char*)g.A + (size_t)nxt.pm * tstep : cA; const char* nB = has_next ? (const char*)g.Bt + (size_t)nxt.pn * tstep : cB;
        for (int t = 0; t < nt; t += 2) {
            const bool last = (t == nt - 2);
            const char* a1 = cA + (size_t)(t + 1) * kstep;
            const char* a2 = last ? nA : cA + (size_t)(t + 2) * kstep; const char* b2 = last ? nB : cB + (size_t)(t + 2) * kstep;
            const char* a3 = a2 + kstep; const char* b3 = b2 + kstep;
            if (last && has_next) S.a_ready(nxt);
            if constexpr (Epi::SCALE) { if (t == nt / 2) E.mid(acc, cur, ui, wr, wc, fr, fq); }
            if constexpr (SP2) {
            PG8_LDB(B0, 0, 0); PG8_LDB(B1, 0, 1); PG8_SCHED; PG8_LDA(At, 0, 0); PG8_STAGE(PG8_SA(1, 1), a1 + hstep, voffA);
            PG8_WAIT_V(8); PG8_WAIT_L(0); PG8_BAR; PG8_MMA(0, 0, At, B0); PG8_MMA(0, 1, At, B1); PG8_BAR; PG8_SCHED;
            PG8_LDA(At, 0, 1); PG8_STAGE(PG8_SB(0, 0), b2, voffB); PG8_STAGE(PG8_SB(0, 1), b2 + hstep, voffB); PG8_STAGE(PG8_SA(0, 0), a2, voffA);
            PG8_WAIT_V(8); PG8_WAIT_L(0); PG8_BAR; PG8_MMA(1, 0, At, B0); PG8_MMA(1, 1, At, B1); PG8_BAR; PG8_SCHED;
            PG8_LDB(B0, 1, 0); PG8_LDB(B1, 1, 1); PG8_SCHED; PG8_LDA(At, 1, 0); PG8_STAGE(PG8_SA(0, 1), a2 + hstep, voffA);
            PG8_WAIT_V(8); PG8_WAIT_L(0); PG8_BAR; PG8_MMA(0, 0, At, B0); PG8_MMA(0, 1, At, B1); PG8_BAR; PG8_SCHED;
            PG8_LDA(At, 1, 1); PG8_STAGE(PG8_SB(1, 0), b3, voffB); PG8_STAGE(PG8_SB(1, 1), b3 + hstep, voffB); PG8_STAGE(PG8_SA(1, 0), a3, voffA);
            PG8_WAIT_V(8); PG8_WAIT_L(0); PG8_BAR; PG8_MMA(1, 0, At, B0); PG8_MMA(1, 1, At, B1); PG8_BAR; PG8_SCHED;
            } else {
            PG8_LDB(B0, 0, 0); PG8_SCHED; PG8_LDA(At, 0, 0); PG8_STAGE(PG8_SA(1, 1), a1 + hstep, voffA);
            PG8_WAIT_L(8); PG8_BAR; PG8_WAIT_L(0); PG8_MMA(0, 0, At, B0); PG8_BAR; PG8_SCHED;
            PG8_LDB(B1, 0, 1); PG8_STAGE(PG8_SB(0, 0), b2, voffB);
            PG8_BAR; PG8_WAIT_L(0); PG8_MMA(0, 1, At, B1); PG8_BAR;
            PG8_LDA(At, 0, 1); PG8_STAGE(PG8_SA(0, 0), a2, voffA);
            PG8_BAR; PG8_WAIT_L(0); PG8_MMA(1, 0, At, B0); PG8_BAR; PG8_SCHED;
            PG8_STAGE(PG8_SB(0, 1), b2 + hstep, voffB);
            PG8_WAIT_V(6); PG8_BAR; PG8_MMA(1, 1, At, B1); PG8_BAR;
            PG8_LDB(B0, 1, 0); PG8_SCHED; PG8_LDA(At, 1, 0); PG8_STAGE(PG8_SA(0, 1), a2 + hstep, voffA);
            PG8_WAIT_L(8); PG8_BAR; PG8_WAIT_L(0); PG8_MMA(0, 0, At, B0); PG8_BAR; PG8_SCHED;
            PG8_LDB(B1, 1, 1); PG8_STAGE(PG8_SB(1, 0), b3, voffB);
            PG8_BAR; PG8_WAIT_L(0); PG8_MMA(0, 1, At, B1); PG8_BAR;
            PG8_LDA(At, 1, 1); PG8_STAGE(PG8_SA(1, 0), a3, voffA);
            PG8_BAR; PG8_WAIT_L(0); PG8_MMA(1, 0, At, B0); PG8_BAR; PG8_SCHED;
            PG8_STAGE(PG8_SB(1, 1), b3 + hstep, voffB);
            PG8_WAIT_V(6); PG8_BAR; PG8_MMA(1, 1, At, B1); PG8_BAR;
            }
        }
        if constexpr (ALIGN_EPI) { if (wr == 0) PG8_BAR; }
        if constexpr (!Epi::AFTER_DRAIN) { E(acc, cur, ui, wr, wc, fr, fq); S.done(cur); }
        if (!has_next) break;
#pragma unroll
        for (int a = 0; a < 2; ++a)
#pragma unroll
            for (int b = 0; b < 2; ++b)
#pragma unroll
                for (int m = 0; m < 4; ++m)
#pragma unroll
                    for (int n = 0; n < 2; ++n) acc[a][b][m][n] = (f32x4){0.f, 0.f, 0.f, 0.f};
        cur = nxt; cA = nA; cB = nB; ++ui;
        if constexpr (ALIGN_EPI) { if (wr == 1) PG8_BAR; }
    }
    PG8_WAIT_V(0);
    if constexpr (!ALIGN_EPI) { if (wr == 0) PG8_BAR; }
    PG8_BAR;
    if constexpr (Epi::AFTER_DRAIN) { E.fused(acc, cur, wr, wc, fr, fq, lds, wid, lane); S.done(cur); }
#undef PG8_SA
#undef PG8_SB
#undef PG8_STAGE
#undef PG8_LDA
#undef PG8_LDB
#undef PG8_MMA
#undef PG8_WAIT_V
#undef PG8_WAIT_L
#undef PG8_BAR
#undef PG8_SCHED
}
}
constexpr int NB = 8, SEQ = 2048, D = 1024, FF = 4096, M = NB * SEQ;
constexpr int DIN = 3072, CONVD = 512, NH = 8, HD = 64;
constexpr int COL_B = 0, COL_C = 512, COL_U = 1024, COL_Q = 1536, COL_K = 2048, COL_V = 2560;
constexpr int NMOD = 6144;
constexpr float EPS = 1e-6f;
constexpr int NWAVES = 8;
constexpr size_t MiB = 1u << 20;
constexpr size_t WS_CTL = 0, CTL_ZERO_BYTES = 1 * MiB;
constexpr size_t WS_SSQA = 320 * 1024, WS_SSQ2 = 384 * 1024, WS_SB = 512 * 1024;
constexpr size_t WS_CEN = 208 * 1024;
constexpr size_t WS_BAR = 256 * 1024;
constexpr size_t WS_WIN = 2 * MiB, WS_WO = 8 * MiB, WS_W1 = 10 * MiB, WS_W2 = 18 * MiB;
constexpr size_t WS_PROJ = 32 * MiB;
constexpr size_t WS_MIX = 128 * MiB;
constexpr size_t WS_H = 32 * MiB;
constexpr size_t WS_XN = 160 * MiB;
constexpr size_t WS_X1B = 192 * MiB;
constexpr size_t WS_END = 256 * MiB;
constexpr int LDS_BYTES = 147456, MISC_OFF = 131072 + 320;

#define LAS __attribute__((address_space(3)))
typedef unsigned short bf16;
typedef unsigned v4u __attribute__((ext_vector_type(4)));
typedef unsigned v2u __attribute__((ext_vector_type(2)));
typedef float f32x4 __attribute__((ext_vector_type(4)));
typedef float f32x16 __attribute__((ext_vector_type(16)));
typedef short bf16x8 __attribute__((ext_vector_type(8)));
typedef short s16x4 __attribute__((ext_vector_type(4)));
#define LDS_WAIT() asm volatile("s_waitcnt lgkmcnt(0)" ::: "memory")

__device__ __forceinline__ unsigned f2bf(float f) { unsigned u = __builtin_bit_cast(unsigned, f); return (u + 0x7fffu + ((u >> 16) & 1u)) >> 16; }
__device__ __forceinline__ unsigned pk2(float lo, float hi) { return f2bf(lo) | (f2bf(hi) << 16); }
typedef float f32x2_t __attribute__((ext_vector_type(2))); typedef __bf16 bf16x2_t __attribute__((ext_vector_type(2)));
__device__ __forceinline__ unsigned cvtpk(float lo, float hi) { f32x2_t v = {lo, hi}; bf16x2_t b = __builtin_convertvector(v, bf16x2_t); return __builtin_bit_cast(unsigned, b); }
__device__ __forceinline__ float bflo(unsigned w) { return __builtin_bit_cast(float, w << 16); }
__device__ __forceinline__ float bfhi(unsigned w) { return __builtin_bit_cast(float, w & 0xffff0000u); }
__device__ __forceinline__ void unpack8(const v4u r, float (&f)[8]) { f[0] = bflo(r.x); f[1] = bfhi(r.x); f[2] = bflo(r.y); f[3] = bfhi(r.y); f[4] = bflo(r.z); f[5] = bfhi(r.z); f[6] = bflo(r.w); f[7] = bfhi(r.w); }
__device__ __forceinline__ v4u pack8(const float (&f)[8]) { v4u o; o.x = cvtpk(f[0], f[1]); o.y = cvtpk(f[2], f[3]); o.z = cvtpk(f[4], f[5]); o.w = cvtpk(f[6], f[7]); return o; }
template <int CTRL> __device__ __forceinline__ float dpp_f(float v) { return __builtin_bit_cast(float, __builtin_amdgcn_mov_dpp(__builtin_bit_cast(int, v), CTRL, 0xF, 0xF, true)); }
__device__ __forceinline__ float sum8(float v) {
    v += dpp_f<0xB1>(v);
    v += dpp_f<0x4E>(v);
    v += dpp_f<0x141>(v);
    return v; }
__device__ __forceinline__ float wave_sum(float v) {
    v = sum8(v); v += dpp_f<0x140>(v);
    const int i = __builtin_bit_cast(int, v);
    return (__builtin_bit_cast(float, __builtin_amdgcn_readlane(i, 0)) + __builtin_bit_cast(float, __builtin_amdgcn_readlane(i, 16)))
         + (__builtin_bit_cast(float, __builtin_amdgcn_readlane(i, 32)) + __builtin_bit_cast(float, __builtin_amdgcn_readlane(i, 48)));
}

__device__ __forceinline__ void p0_transpose_item(const float* W, int K, int N, bf16* WT, LAS float* scr, int item, int lane) {
    const int nblk = N / 32, kb = item / nblk, nb = item % nblk, k0 = 64 * kb, n0 = 32 * nb;
    float wv[32];
#pragma unroll
    for (int i = 0; i < 32; ++i) { const int kk = 2 * i + (lane >> 5); wv[i] = __builtin_nontemporal_load(W + (size_t)(k0 + kk) * N + n0 + (lane & 31)); }
#pragma unroll
    for (int i = 0; i < 32; ++i) { const int kk = 2 * i + (lane >> 5); scr[kk * 33 + (lane & 31)] = wv[i]; }
    LDS_WAIT(); asm volatile("" ::: "memory");
    const int c = lane & 7;
#pragma unroll
    for (int j = 0; j < 4; ++j) { const int n = (lane >> 3) + 8 * j; const LAS float* s = scr + (8 * c) * 33 + n;
        v4u o; o.x = cvtpk(s[0 * 33], s[1 * 33]); o.y = cvtpk(s[2 * 33], s[3 * 33]); o.z = cvtpk(s[4 * 33], s[5 * 33]); o.w = cvtpk(s[6 * 33], s[7 * 33]);
        *(v4u*)(WT + (size_t)(n0 + n) * K + k0 + 8 * c) = o; }
    LDS_WAIT(); asm volatile("" ::: "memory");
}
__device__ __forceinline__ void p0_transpose_wo_item(const float* W, const float* gattn, bf16* WT, LAS float* scr, int item, int lane) {
    constexpr int K = 1024, N = 1024;
    const int nblk = N / 32, kb = item / nblk, nb = item % nblk, k0 = 64 * kb, n0 = 32 * nb;
    float wv[32];
#pragma unroll
    for (int i = 0; i < 32; ++i) { const int kk = 2 * i + (lane >> 5); wv[i] = __builtin_nontemporal_load(W + (size_t)(k0 + kk) * N + n0 + (lane & 31)); }
#pragma unroll
    for (int i = 0; i < 32; ++i) { const int kk = 2 * i + (lane >> 5); float w = wv[i]; if (k0 >= 512) w *= gattn[k0 - 512 + kk]; scr[kk * 33 + (lane & 31)] = w; }
    LDS_WAIT(); asm volatile("" ::: "memory");
    const int c = lane & 7, kd = (k0 + 512) & 1023;
#pragma unroll
    for (int j = 0; j < 4; ++j) { const int n = (lane >> 3) + 8 * j; const LAS float* s = scr + (8 * c) * 33 + n;
        v4u o; o.x = cvtpk(s[0 * 33], s[1 * 33]); o.y = cvtpk(s[2 * 33], s[3 * 33]); o.z = cvtpk(s[4 * 33], s[5 * 33]); o.w = cvtpk(s[6 * 33], s[7 * 33]);
        *(v4u*)(WT + (size_t)(n0 + n) * K + kd + 8 * c) = o; }
    LDS_WAIT(); asm volatile("" ::: "memory");
}
__device__ __forceinline__ void p0_gemv_item(const float* cvec, const float* wada, float* modacc, int item, int lane) {
    const int jb = item % 96, kc = item / 96, j = 64 * jb + lane, k0 = 64 * kc;
    float s[8], acc[8];
#pragma unroll
    for (int b = 0; b < 8; ++b) { const float v = cvec[b * D + k0 + lane]; s[b] = v / (1.f + __expf(-v)); acc[b] = 0.f; }
    const float* wp = wada + (size_t)k0 * NMOD + j;
#pragma unroll 32
    for (int kk = 0; kk < 64; ++kk) { const float w = __builtin_nontemporal_load(wp + (size_t)kk * NMOD);
#pragma unroll
        for (int b = 0; b < 8; ++b) acc[b] += __builtin_bit_cast(float, __builtin_amdgcn_readlane(__builtin_bit_cast(int, s[b]), kk)) * w; }
#pragma unroll
    for (int b = 0; b < 8; ++b) atomicAdd(modacc + b * NMOD + j, acc[b]);
}

__device__ __forceinline__ void p1_sb_row(const LAS float* sh, const bf16* W1t, float* sb, int n, int lane) {
    float acc[8];
#pragma unroll
    for (int b = 0; b < 8; ++b) acc[b] = 0.f;
#pragma unroll
    for (int j = 0; j < 4; ++j) { const v2u w = *(const v2u*)(W1t + (size_t)n * D + 256 * j + 4 * lane);
        const float w0 = bflo(w.x), w1 = bfhi(w.x), w2 = bflo(w.y), w3 = bfhi(w.y);
#pragma unroll
        for (int b = 0; b < 8; ++b) { const f32x4 s = *(const LAS f32x4*)(sh + b * D + 256 * j + 4 * lane); acc[b] += (s.x * w0 + s.y * w1) + (s.z * w2 + s.w * w3); } }
#pragma unroll
    for (int b = 0; b < 8; ++b) { const float t = wave_sum(acc[b]); if (lane == 0) sb[b * FF + n] = t; }
}
__device__ __forceinline__ void p1_sb_row1(const LAS float* sh, const bf16* W1t, float* sbrow, int n, int lane) {
    float acc = 0.f;
#pragma unroll
    for (int j = 0; j < 4; ++j) { const v2u w = *(const v2u*)(W1t + (size_t)n * D + 256 * j + 4 * lane); const f32x4 s = *(const LAS f32x4*)(sh + 256 * j + 4 * lane);
        acc += (s.x * bflo(w.x) + s.y * bfhi(w.x)) + (s.z * bflo(w.y) + s.w * bfhi(w.y)); }
    const float t = wave_sum(acc); if (lane == 0) sbrow[n] = t;
}
__device__ __forceinline__ void norm_mod_pass(const float* __restrict__ X, const float* __restrict__ g, const float* __restrict__ modacc, const float* __restrict__ bada, int shift_idx, int scale_idx, bf16* __restrict__ XN, int gw, int NGW, int lane) {
    for (int item = gw; item < M / 8; item += NGW) {
        const int row0 = item * 8, b = row0 / SEQ;
        f32x4 a[4], s[4];
#pragma unroll
        for (int j = 0; j < 4; ++j) { const int col = 4 * lane + 256 * j;
            const f32x4 gg = *(const f32x4*)(g + col);
            const f32x4 sc = *(const f32x4*)(modacc + b * NMOD + scale_idx * D + col) + *(const f32x4*)(bada + scale_idx * D + col);
            s[j] = *(const f32x4*)(modacc + b * NMOD + shift_idx * D + col) + *(const f32x4*)(bada + shift_idx * D + col);
            a[j] = gg * (sc + 1.0f); }
#pragma unroll 4
        for (int r = 0; r < 8; ++r) { const float* xr = X + (size_t)(row0 + r) * D + 4 * lane;
            f32x4 v[4]; float ss = 0.f;
#pragma unroll
            for (int j = 0; j < 4; ++j) { v[j] = __builtin_nontemporal_load((const f32x4*)(xr + 256 * j)); ss += (v[j].x * v[j].x + v[j].y * v[j].y) + (v[j].z * v[j].z + v[j].w * v[j].w); }
            const float rinv = 1.0f / sqrtf(wave_sum(ss) * (1.f / D) + EPS);
            bf16* orow = XN + (size_t)(row0 + r) * D + 4 * lane;
#pragma unroll
            for (int j = 0; j < 4; ++j) { const f32x4 y = v[j] * rinv * a[j] + s[j]; v2u o; o.x = cvtpk(y.x, y.y); o.y = cvtpk(y.z, y.w); *(v2u*)(orow + 256 * j) = o; } }
    }
}

__device__ __forceinline__ void conv_norm_pass(const bf16* __restrict__ PROJ, const float* __restrict__ convw, const float* __restrict__ gconv, bf16* __restrict__ MIX, int gw, int NGW, int lane) {
    const int c = 8 * lane;
    for (int item = gw; item < M / 8; item += NGW) {
        const int row0 = item * 8, t0 = row0 % SEQ;
        float w0[8], w1[8], w2[8], gc[8];
#pragma unroll
        for (int e = 0; e < 8; ++e) { w0[e] = convw[c + e]; w1[e] = convw[CONVD + c + e]; w2[e] = convw[2 * CONVD + c + e]; gc[e] = gconv[c + e]; }
        float cm2[8], cm1[8];
#pragma unroll
        for (int e = 0; e < 8; ++e) { cm2[e] = 0.f; cm1[e] = 0.f; }
        if (t0 != 0) { float a[8], u[8];
            unpack8(*(const v4u*)(PROJ + (size_t)(row0 - 2) * DIN + COL_C + c), a); unpack8(*(const v4u*)(PROJ + (size_t)(row0 - 2) * DIN + COL_U + c), u);
#pragma unroll
            for (int e = 0; e < 8; ++e) cm2[e] = a[e] * u[e];
            unpack8(*(const v4u*)(PROJ + (size_t)(row0 - 1) * DIN + COL_C + c), a); unpack8(*(const v4u*)(PROJ + (size_t)(row0 - 1) * DIN + COL_U + c), u);
#pragma unroll
            for (int e = 0; e < 8; ++e) cm1[e] = a[e] * u[e]; }
#pragma unroll
        for (int r = 0; r < 8; ++r) { const size_t row = (size_t)(row0 + r);
            float bg[8], cgv[8], u[8], y[8];
            unpack8(__builtin_nontemporal_load((const v4u*)(PROJ + row * DIN + COL_B + c)), bg); unpack8(__builtin_nontemporal_load((const v4u*)(PROJ + row * DIN + COL_C + c)), cgv); unpack8(__builtin_nontemporal_load((const v4u*)(PROJ + row * DIN + COL_U + c)), u);
            float ss = 0.f;
#pragma unroll
            for (int e = 0; e < 8; ++e) { const float cu = cgv[e] * u[e]; y[e] = bg[e] * (w0[e] * cm2[e] + w1[e] * cm1[e] + w2[e] * cu); cm2[e] = cm1[e]; cm1[e] = cu; ss += y[e] * y[e]; }
            const float rc = 1.0f / sqrtf(wave_sum(ss) * (1.f / CONVD) + EPS);
#pragma unroll
            for (int e = 0; e < 8; ++e) y[e] = y[e] * rc * gc[e];
            *(v4u*)(MIX + row * D + CONVD + c) = pack8(y); }
    }
}

namespace sba {
constexpr float C2 = 0.125f * 1.4426950408889634f;
constexpr int SLOT = 16384, VOFF = 8192, NSLOT = 5, FLAG_OFF = NSLOT * SLOT, STG_OFF = NSLOT * SLOT + 256;
constexpr float THR_EXIT = 48.0f;
__device__ __forceinline__ int crow(int r, int hi) { return (r & 3) + 8 * (r >> 2) + 4 * hi; }
typedef short v4i16_t __attribute__((ext_vector_type(4)));
__device__ __forceinline__ s16x4 vtr(const LAS unsigned char* p) { return __builtin_bit_cast(s16x4, __builtin_amdgcn_ds_read_tr16_b64_v4i16((LAS v4i16_t*)p)); }

__device__ __forceinline__ void attn_unit(int b, int h, int qb, const bf16* PROJ, const float* gq, const float* gk, bf16* MIX, float* ssq_a, LAS unsigned char* lds) {
    const int wid = __builtin_amdgcn_readfirstlane(threadIdx.x >> 6); const int lane = lane_now(), tid = wid * 64 + lane, r32 = lane & 31, hi = lane >> 5;
    const size_t rowbase = (size_t)b * SEQ; const int q0 = qb * 256;
    const int rb = (wid < 4) ? wid : (wid ^ 1);
    const int key_s = tid >> 3, piece = tid & 7;
    const bf16* Kg = PROJ + (rowbase + key_s) * DIN + COL_K + h * HD + piece * 8;
    const bf16* Vg = PROJ + (rowbase + key_s) * DIN + COL_V + h * HD + piece * 8;
    float gkv[8];
#pragma unroll
    for (int e = 0; e < 8; ++e) gkv[e] = gk[piece * 8 + e];
    const int kdst = piece * 1024 + key_s * 16, vdst = VOFF + (piece >> 2) * 4096 + key_s * 64 + (piece & 3) * 16;
    const int ktw = 4 * qb + (rb >> 1);
    f32x16 o0 = {}, o1 = {}; float carry = 0.f;
    const int vrd = VOFF + ((lane >> 4) & 1) * 32 + (lane & 3) * 8 + (4 * hi + ((lane & 15) >> 2)) * 64;
#define SBA_STAGE(KRAW, VRAW, KT) do { float kf[8]; unpack8(KRAW, kf); float ss_ = 0.f; \
        _Pragma("unroll") for (int e = 0; e < 8; ++e) ss_ += kf[e] * kf[e]; \
        ss_ = sum8(ss_); \
        const float rk_ = __builtin_amdgcn_rsqf(ss_ * (1.f / HD) + EPS); \
        _Pragma("unroll") for (int e = 0; e < 8; ++e) kf[e] = kf[e] * rk_ * gkv[e]; \
        const int so_ = ((KT) % NSLOT) * SLOT; *(LAS v4u*)(lds + so_ + kdst) = pack8(kf); *(LAS v4u*)(lds + so_ + vdst) = VRAW; } while (0)
    v4u k4[4], v4[4];
#pragma unroll
    for (int j = 0; j < 4; ++j) { k4[j] = *(const v4u*)(Kg + (size_t)(4 * qb + j) * 64 * DIN); v4[j] = *(const v4u*)(Vg + (size_t)(4 * qb + j) * 64 * DIN); }
    bf16x8 qr[4];
    { const bf16* Qw = PROJ + (rowbase + q0 + rb * 32 + r32) * DIN + COL_Q + h * HD + hi * 8;
      float qf[4][8]; float ss = 0.f;
#pragma unroll
      for (int d0 = 0; d0 < 4; ++d0) { unpack8(*(const v4u*)(Qw + d0 * 16), qf[d0]);
#pragma unroll
          for (int e = 0; e < 8; ++e) ss += qf[d0][e] * qf[d0][e]; }
      { auto rr_ = __builtin_amdgcn_permlane32_swap(__float_as_uint(ss), __float_as_uint(ss), false, false); ss = __uint_as_float(rr_[0]) + __uint_as_float(rr_[1]); }
      const float rq = C2 * __builtin_amdgcn_rsqf(ss * (1.f / HD) + EPS);
#pragma unroll
      for (int d0 = 0; d0 < 4; ++d0) { float t[8];
#pragma unroll
          for (int e = 0; e < 8; ++e) t[e] = qf[d0][e] * rq * gq[d0 * 16 + hi * 8 + e];
          qr[d0] = __builtin_bit_cast(bf16x8, pack8(t)); } }
#pragma unroll
    for (int j = 0; j < 4; ++j) SBA_STAGE(k4[j], v4[j], 4 * qb + j);
    v4u kraw = {}, vraw = {};
    if (qb > 0) { kraw = *(const v4u*)(Kg + (size_t)(4 * qb - 1) * 64 * DIN); vraw = *(const v4u*)(Vg + (size_t)(4 * qb - 1) * 64 * DIN); }
    bool wdone = false;
    for (int s = 0; ; ++s) {
        if (s > 0) { const int n = 4 * qb - s;
            if (n >= 0) SBA_STAGE(kraw, vraw, n);
            if (n >= 1) { kraw = *(const v4u*)(Kg + (size_t)(n - 1) * 64 * DIN); vraw = *(const v4u*)(Vg + (size_t)(n - 1) * 64 * DIN); } }
        __syncthreads();
        if (s > 0) {
            const LAS unsigned* fl = (const LAS unsigned*)(lds + FLAG_OFF) + ((s - 1) & 1) * 8;
            const v4u f0 = *(const LAS v4u*)fl, f1 = *(const LAS v4u*)(fl + 4);
            if (__builtin_amdgcn_readfirstlane((f0.x & f0.y) & (f0.z & f0.w) & (f1.x & f1.y) & (f1.z & f1.w)) != 0u) break; }
        const int kt = ktw - s;
        if (kt >= 0 && !wdone) {
            const int slot = (kt % NSLOT) * SLOT;
            const bool diag = (s == 0); const int qrel = (q0 + rb * 32 + r32) - kt * 64;
#pragma unroll
            for (int blk = 1; blk >= 0; --blk) {
                if (blk == 1 && diag && (rb & 1) == 0) continue;
                if (blk == 0 && wdone) break;
                f32x16 p = {};
                const LAS unsigned char* kb = lds + slot + hi * 1024 + r32 * 16 + blk * 512;
#pragma unroll
                for (int d0 = 0; d0 < 4; ++d0) { const bf16x8 b0 = *(const LAS bf16x8*)(kb + d0 * 2048); p = __builtin_amdgcn_mfma_f32_32x32x16_bf16(b0, qr[d0], p, 0, 0, 0); }
                f32x16 sp;
#pragma unroll
                for (int r = 0; r < 16; ++r) {
                    float z = __builtin_amdgcn_fmed3f(p[r], 64.f, -INFINITY); float t = __builtin_amdgcn_logf(1.0f + __builtin_amdgcn_exp2f(z));
                    if (diag && 32 * blk + crow(r, hi) >= qrel) { t = 0.f; z = -INFINITY; }
                    sp[r] = t; p[r] = z; }
                float pairs[4], Bown[4];
#pragma unroll
                for (int j = 0; j < 4; ++j) {
                    const float own = (sp[4 * j] + sp[4 * j + 1]) + (sp[4 * j + 2] + sp[4 * j + 3]);
                    auto rr = __builtin_amdgcn_permlane32_swap(__float_as_uint(own), __float_as_uint(own), false, false);
                    const float glo = __uint_as_float(rr[0]), ghi = __uint_as_float(rr[1]);
                    pairs[j] = glo + ghi; Bown[j] = hi ? 0.f : ghi; }
                { float base = carry;
#pragma unroll
                  for (int j = 3; j >= 0; --j) { Bown[j] += base; base += pairs[j]; }
                  carry = base; }
#pragma unroll
                for (int j = 0; j < 4; ++j) {
                    float rem = Bown[j] + sp[4 * j + 3];
                    p[4 * j + 3] = __builtin_amdgcn_exp2f(p[4 * j + 3] - rem); rem += sp[4 * j + 2];
                    p[4 * j + 2] = __builtin_amdgcn_exp2f(p[4 * j + 2] - rem); rem += sp[4 * j + 1];
                    p[4 * j + 1] = __builtin_amdgcn_exp2f(p[4 * j + 1] - rem); rem += sp[4 * j + 0];
                    p[4 * j + 0] = __builtin_amdgcn_exp2f(p[4 * j + 0] - rem); }
                v4u pw[2];
                pw[0] = (v4u){cvtpk(p[0], p[1]), cvtpk(p[2], p[3]), cvtpk(p[4], p[5]), cvtpk(p[6], p[7])};
                pw[1] = (v4u){cvtpk(p[8], p[9]), cvtpk(p[10], p[11]), cvtpk(p[12], p[13]), cvtpk(p[14], p[15])};
                const LAS unsigned char* vp = lds + slot + vrd + blk * 2048;
#pragma unroll
                for (int ks = 0; ks < 2; ++ks) {
                    const s16x4 l0 = vtr(vp + ks * 1024), h0 = vtr(vp + ks * 1024 + 512), l1 = vtr(vp + 4096 + ks * 1024), h1 = vtr(vp + 4096 + ks * 1024 + 512);
                    const bf16x8 v0 = (bf16x8){l0[0], l0[1], l0[2], l0[3], h0[0], h0[1], h0[2], h0[3]}, v1 = (bf16x8){l1[0], l1[1], l1[2], l1[3], h1[0], h1[1], h1[2], h1[3]};
                    o0 = __builtin_amdgcn_mfma_f32_32x32x16_bf16(__builtin_bit_cast(bf16x8, pw[ks]), v0, o0, 0, 0, 0);
                    o1 = __builtin_amdgcn_mfma_f32_32x32x16_bf16(__builtin_bit_cast(bf16x8, pw[ks]), v1, o1, 0, 0, 0); }
                wdone = __all(carry >= THR_EXIT);
            }
        }
        { const unsigned fin = (wdone || kt <= 0) ? 1u : 0u; if (lane == 0) ((LAS unsigned*)(lds + FLAG_OFF))[(s & 1) * 8 + wid] = fin; }
    }
#undef SBA_STAGE
    { LAS bf16* stg = (LAS bf16*)(lds + STG_OFF + wid * 4096);
#pragma unroll
      for (int r = 0; r < 16; ++r) { const int orow = crow(r, hi); stg[orow * 64 + r32] = (bf16)f2bf(o0[r]); stg[orow * 64 + 32 + r32] = (bf16)f2bf(o1[r]); }
      LDS_WAIT();
      bf16* Ow = MIX + (rowbase + q0 + rb * 32) * D + h * HD;
#pragma unroll
      for (int i = 0; i < 4; ++i) { const int row = i * 8 + (lane >> 3), ch = lane & 7; const v4u v = *(const LAS v4u*)(stg + row * 64 + ch * 8);
          *(v4u*)(Ow + (size_t)row * D + ch * 8) = v;
          float f[8]; unpack8(v, f); float ss = 0.f;
#pragma unroll
          for (int e = 0; e < 8; ++e) ss += f[e] * f[e];
          ss = sum8(ss);
          if (ch == 0) atomicAdd(ssq_a + rowbase + q0 + rb * 32 + row, ss); } }
    __syncthreads();
}
}

#define XB_TMO      128
#define XB_XCNT(j)  (256  + 64 * (j))
#define XB_XSUB(j)  (1280 + 64 * (j))
#define XB_XGEN(j)  (2304 + 64 * (j))
#define XB_TOP      3328
#define XB_TOPGEN   3392
#define XCD_BAR_WORDS 3456
#define XB_SPIN_CAP (1u << 18)

__device__ __forceinline__ unsigned xb_ld(unsigned* p)              { return __hip_atomic_load(p, __ATOMIC_RELAXED, __HIP_MEMORY_SCOPE_AGENT); }
__device__ __forceinline__ unsigned xb_add(unsigned* p, unsigned v) { return __hip_atomic_fetch_add(p, v, __ATOMIC_RELAXED, __HIP_MEMORY_SCOPE_AGENT); }
__device__ __forceinline__ unsigned xb_xcc_id() { return (unsigned)__builtin_amdgcn_s_getreg((3 << 11) | 20) & 0xFu; }
#define XB_SPIN(cond, bar) do { unsigned _sp = 0; while (cond) { __builtin_amdgcn_s_sleep(1); \
    if ((++_sp & 255u) == 0u) { if (xb_ld(&(bar)[XB_TMO])) break; if (_sp > XB_SPIN_CAP) { atomicAdd(&(bar)[XB_TMO], 1u); break; } } } } while (0)

struct XcdBarrier {
    unsigned* bar; unsigned x;
    volatile LAS unsigned* st;
};

__device__ __forceinline__ XcdBarrier xcd_barrier_post(unsigned* bar, volatile LAS unsigned* st) {
    XcdBarrier b; b.bar = bar; b.x = xb_xcc_id(); b.st = st;
    if (threadIdx.x == 0) (void)xb_add(&bar[XB_XCNT(b.x)], 1u);
    return b;
}
__device__ __forceinline__ void xcd_barrier_complete(unsigned* bar, unsigned x, unsigned& nloc, unsigned& nx) {
    const unsigned G = gridDim.x * gridDim.y * gridDim.z;
    unsigned sum, cnt, mine, sp = 0u;
    for (;;) {
        sum = 0u; cnt = 0u; mine = 0u;
#pragma unroll
        for (unsigned j = 0; j < 16; ++j) { const unsigned c = xb_ld(&bar[XB_XCNT(j)]); sum += c; cnt += (c > 0u) ? 1u : 0u; mine = (j == x) ? c : mine; }
        if (sum == G) break;
        __builtin_amdgcn_s_sleep(1);
        if ((++sp & 255u) == 0u) { if (xb_ld(&bar[XB_TMO])) break; if (sp > XB_SPIN_CAP) { atomicAdd(&bar[XB_TMO], 1u); break; } }
    }
    nloc = mine > 0u ? mine : 1u; nx = cnt > 0u ? cnt : 1u;
}

__device__ __forceinline__ void xcd_barrier(const XcdBarrier& b, bool local = false) {
    asm volatile("s_waitcnt vmcnt(0)" ::: "memory");
    __syncthreads();
    if (threadIdx.x == 0) {
        unsigned* bar = b.bar;
        __builtin_amdgcn_s_waitcnt(0);
        unsigned nloc = b.st[0], nx = b.st[1];
        if (nloc == 0u) { xcd_barrier_complete(bar, b.x, nloc, nx); b.st[0] = nloc; b.st[1] = nx; }
        const unsigned old = xb_add(&bar[XB_XSUB(b.x)], 1u);
        const unsigned gen = old / nloc;
        if (old + 1u == (gen + 1u) * nloc) {
            if (!local) __builtin_amdgcn_fence(__ATOMIC_RELEASE, "agent");
            asm volatile("s_waitcnt vmcnt(0)" ::: "memory");
            if (!local) {
            const unsigned og = xb_add(&bar[XB_TOP], 1u);
            const unsigned tg = og / nx;
            if (og + 1u == (tg + 1u) * nx) xb_add(&bar[XB_TOPGEN], 1u);
            else XB_SPIN(xb_ld(&bar[XB_TOPGEN]) == tg, bar);
            }
            __builtin_amdgcn_fence(__ATOMIC_ACQUIRE, "agent");
            xb_add(&bar[XB_XGEN(b.x)], 1u);
            asm volatile("s_waitcnt vmcnt(0)" ::: "memory");
        } else {
            __builtin_amdgcn_fence(__ATOMIC_ACQUIRE, "agent");
            XB_SPIN(xb_ld(&bar[XB_XGEN(b.x)]) == gen, bar);
            asm volatile("" ::: "memory");
            asm volatile("s_waitcnt vmcnt(0)" ::: "memory");
        }
    }
    __syncthreads();
}

#ifndef PROBE_DUP
#define PROBE_DUP (-1)
#endif
#ifndef SEAM_LOCAL_ENABLE
#define SEAM_LOCAL_ENABLE 1
#endif
struct Args { const float* in[15]; float* out; unsigned char* ws; int ph_lo, ph_hi, coop, pad; };
constexpr int N_PHASES = 7;
__global__ void __launch_bounds__(NWAVES * 64, 2) mk_fwd(Args args) {
    extern __shared__ __attribute__((aligned(16))) unsigned char lds_raw[];
    LAS unsigned char* lds = (LAS unsigned char*)lds_raw;
    const int wave = __builtin_amdgcn_readfirstlane(threadIdx.x >> 6);
#define tid (wave * 64 + lane_now())
#define lane lane_now()
    const int G = gridDim.x; const int bx = blockIdx.x; const int vcu = (G % 8 == 0) ? (bx % 8) * (G / 8) + bx / 8 : bx;
    const int gw = vcu * NWAVES + wave, NGW = G * NWAVES;
    const float* x = args.in[0]; const float* cvec = args.in[1]; const float* wada = args.in[2]; const float* bada = args.in[3]; const float* g1 = args.in[4];
    const float* win = args.in[5]; const float* convw = args.in[6]; const float* gq = args.in[7]; const float* gk = args.in[8]; const float* gconv = args.in[9];
    const float* gattn = args.in[10]; const float* wout = args.in[11]; const float* g2 = args.in[12]; const float* wff1 = args.in[13]; const float* wff2 = args.in[14];
    float* out = args.out; unsigned char* ws = args.ws;
    float* modacc = (float*)(ws + WS_CTL);
    bf16* Win_t = (bf16*)(ws + WS_WIN); bf16* Wo_t = (bf16*)(ws + WS_WO); bf16* W1_t = (bf16*)(ws + WS_W1); bf16* W2_t = (bf16*)(ws + WS_W2);
    bf16* PROJ = (bf16*)(ws + WS_PROJ); bf16* MIX = (bf16*)(ws + WS_MIX); bf16* HB = (bf16*)(ws + WS_H); bf16* XN = (bf16*)(ws + WS_XN); bf16* X1B = (bf16*)(ws + WS_X1B);
    const int lo = args.ph_lo, hi = args.ph_hi;
    volatile LAS unsigned* MISC = (volatile LAS unsigned*)(lds + MISC_OFF);
    if (tid < 32) MISC[tid] = 0u;
    __syncthreads();
    XcdBarrier bar; bar.bar = (unsigned*)(ws + WS_BAR); bar.x = 0; bar.st = nullptr;
    if (args.coop) bar = xcd_barrier_post((unsigned*)(ws + WS_BAR), MISC + 8);
    unsigned* cen = (unsigned*)(ws + WS_CEN);
    if (args.coop && G == 256 && threadIdx.x == 0) { const unsigned xc = xb_xcc_id(); atomicMax(&cen[vcu >> 5], xc + 1u); atomicMax(&cen[8 + (vcu >> 5)], 16u - xc); }
    int seam_local = 0;
#define IN(k) (lo <= (k) && (k) < hi)
#define SEAM(k) do { if (IN(k) && IN((k) + 1)) { xcd_barrier(bar, (k) > 0 && seam_local != 0); } } while (0)

    float* ssq_a = (float*)(ws + WS_SSQA); float* ssq2 = (float*)(ws + WS_SSQ2); float* sbv = (float*)(ws + WS_SB);
    float* scrf = (float*)(ws + 224 * MiB);
    const int alt = args.pad;
    if (IN(0)) {
        LAS float* scr = (LAS float*)(lds + wave * 16384);
        constexpr int I_IN = (D / 64) * (DIN / 32), I_O = (D / 64) * (D / 32), I_1 = (D / 64) * (FF / 32), I_2 = (FF / 64) * (D / 32), I_G = 16 * 96;
        constexpr int NITEMS = I_G + I_IN + I_O + I_1 + I_2;
        for (int it = gw; it < NITEMS; it += NGW) {
            int r = it;
            if (r < I_G) { p0_gemv_item(cvec, wada, alt ? scrf : modacc, r, lane); continue; } r -= I_G;
            if (r < I_IN) { p0_transpose_item(win, D, DIN, Win_t, scr, r, lane); continue; } r -= I_IN;
            if (r < I_O) { p0_transpose_wo_item(wout, gattn, Wo_t, scr, r, lane); continue; } r -= I_O;
            if (r < I_1) { p0_transpose_item(wff1, D, FF, W1_t, scr, r, lane); continue; } r -= I_1;
            p0_transpose_item(wff2, FF, D, W2_t, scr, r, lane);
        }
    }
    SEAM(0);
    if (args.coop && G == 256) { unsigned ok = 1u;
#pragma unroll
        for (int g_ = 0; g_ < 8; ++g_) { const unsigned a_ = xb_ld(&cen[g_]), b_ = xb_ld(&cen[8 + g_]); ok &= (a_ != 0u && a_ - 1u == 16u - b_) ? 1u : 0u; }
        seam_local = (int)__builtin_amdgcn_readfirstlane(ok) & SEAM_LOCAL_ENABLE; }
    if (IN(1)) { LAS float* sh = (LAS float*)lds;
        if (G == 256) {
            const int bg = vcu >> 5;
            for (int i = tid; i < D; i += NWAVES * 64) sh[i] = modacc[bg * NMOD + 3 * D + i] + bada[3 * D + i];
            __syncthreads();
            for (int n = (vcu & 31) * NWAVES + wave; n < FF; n += 32 * NWAVES) p1_sb_row1(sh, W1_t, sbv + bg * FF, n, lane);
        } else {
        for (int i = tid; i < 8 * D; i += NWAVES * 64) sh[i] = modacc[(i >> 10) * NMOD + 3 * D + (i & 1023)] + bada[3 * D + (i & 1023)];
        __syncthreads();
        for (int n = gw; n < FF; n += NGW) p1_sb_row(sh, W1_t, sbv, n, lane);
        }
        norm_mod_pass(x, g1, modacc, bada, 0, 1, XN, gw, NGW, lane);
        __syncthreads(); }
    SEAM(1);
    if (IN(2)) { pg8::Gemm g{XN, Win_t, M, DIN, D}; pg8::StaticOrder S; S.init(M, DIN, G, bx); pg8::EpiStore<0> E{PROJ, DIN};
        pg8::gemm_phase<pg8::EpiStore<0>, pg8::StaticOrder, true, true>(lds, g, S, E); }
    SEAM(2);
    if (IN(3)) { for (int j = vcu; j < 512; j += G) { const int jj = j & 255, bh = jj >> 2, s = jj & 3, qb = (j < 256) ? s : 7 - s;
            sba::attn_unit(bh >> 3, bh & 7, qb, PROJ, gq, gk, MIX, alt ? scrf : ssq_a, lds); }
        conv_norm_pass(PROJ, convw, gconv, MIX, gw, NGW, lane); }
    SEAM(3);
    if (IN(4)) { pg8::Gemm g{MIX, Wo_t, M, D, D}; pg8::StaticOrder S; S.init(M, D, G, bx); pg8::EpiWo E{x, X1B, XN, modacc, bada, g2, ssq_a, alt ? scrf : ssq2, lds};
        { pg8::Unit u0; if (S.next(0, u0)) E.pre(u0, 0, tid); __syncthreads(); }
        pg8::gemm_phase<pg8::EpiWo, pg8::StaticOrder, false, true>(lds, g, S, E); }
    SEAM(4);
    if (IN(5)) { pg8::Gemm g{XN, W1_t, M, FF, D}; pg8::StaticOrder S; S.init(M, FF, G, bx); pg8::EpiUp E{HB, ssq2, sbv};
        pg8::gemm_phase<pg8::EpiUp, pg8::StaticOrder, true, true>(lds, g, S, E); }
    SEAM(5);
    if (IN(6)) { pg8::Gemm g{HB, W2_t, M, D, FF}; pg8::StaticOrder S; S.init(M, D, G, bx); pg8::EpiResGate E{X1B, alt ? scrf : out, modacc, bada, 5 * D, lds};
        { pg8::Unit u0; if (S.next(0, u0)) E.pre(u0, 0, tid); __syncthreads(); }
        pg8::gemm_phase<pg8::EpiResGate, pg8::StaticOrder, false, true>(lds, g, S, E); }
#undef IN
#undef SEAM
#undef tid
#undef lane
}

#ifndef MK_SPLIT
#define MK_SPLIT 0
#endif
extern "C" void kernel_launch(void* const* d_in, const int* in_sizes, int n_in, void* d_out, int out_size, void* d_ws, size_t ws_size, hipStream_t stream) {
    static int grid = 0;
    if (grid == 0) {
        int dev = 0, cus = 0, per_cu = 0;
        if (n_in != 15 || out_size != M * D || ws_size < WS_END) { fprintf(stderr, "kernel_launch: unexpected shapes\n"); grid = -1; return; }
        hipGetDevice(&dev); hipDeviceGetAttribute(&cus, hipDeviceAttributeMultiprocessorCount, dev);
        if (hipFuncSetAttribute((const void*)mk_fwd, hipFuncAttributeMaxDynamicSharedMemorySize, LDS_BYTES) != hipSuccess) { fprintf(stderr, "kernel_launch: hipFuncSetAttribute failed\n"); grid = -1; return; }
        if (hipOccupancyMaxActiveBlocksPerMultiprocessor(&per_cu, (const void*)mk_fwd, NWAVES * 64, LDS_BYTES) != hipSuccess || per_cu < 1) { fprintf(stderr, "kernel_launch: the occupancy query reports %d resident workgroups per CU for this kernel; a grid-wide barrier needs at least 1; nothing launched\n", per_cu); grid = -1; return; }
        (void)hipGetLastError();
        if (cus != 256) { fprintf(stderr, "kernel_launch: built for a 256-CU device (one 256x256 unit per workgroup in the N=1024 GEMM phases); got %d CUs\n", cus); grid = -1; return; }
        grid = cus * (per_cu < 1 ? per_cu : 1);
    }
    if (grid < 0) return;
    (void)hipMemsetAsync((char*)d_ws + WS_CTL, 0, CTL_ZERO_BYTES, stream);
    Args a{};
    for (int i = 0; i < 15; ++i) a.in[i] = (const float*)d_in[i];
    a.out = (float*)d_out; a.ws = (unsigned char*)d_ws;
#if MK_SPLIT
    for (int p = 0; p < N_PHASES; ++p) { a.ph_lo = p; a.ph_hi = p + 1; a.coop = 0; a.pad = 0; hipLaunchKernelGGL(mk_fwd, dim3(grid), dim3(NWAVES * 64), LDS_BYTES, stream, a);
        if (p == PROBE_DUP) { a.pad = 1; hipLaunchKernelGGL(mk_fwd, dim3(grid), dim3(NWAVES * 64), LDS_BYTES, stream, a); } }
#else
    a.ph_lo = 0; a.ph_hi = N_PHASES; a.coop = 1;
    void* kargs[] = {&a};
    hipError_t e = hipLaunchCooperativeKernel((const void*)mk_fwd, dim3(grid), dim3(NWAVES * 64), kargs, LDS_BYTES, stream);
    if (e != hipSuccess) fprintf(stderr, "kernel_launch: cooperative launch failed: %s (grid %d)\n", hipGetErrorString(e), grid);
#endif
}
```
